# Optimizing an MI355X kernel written in HIP

```python
import math
import jax, jax.numpy as jnp
from jax import lax
import numpy as np

D_MODEL = 1024
BATCH = 2
SEQ = 16384
DEPTH = 2

N_META = 16
BLOCK_Q = 128
ROPE_THETA = 10000.0
RMS_EPS = 1e-6
DA_HEADS = 8
DA_HEAD_DIM = 64
DSA_HEADS = 16
DSA_HEAD_DIM = 64
IDX_HEADS = 8
IDX_DIM = 64
TOPK_MAX = 256
DSA_QKV = DSA_HEADS * DSA_HEAD_DIM
DSA_SPLITS = [DSA_QKV, 2 * DSA_QKV, 3 * DSA_QKV,
              3 * DSA_QKV + IDX_HEADS * IDX_DIM,
              3 * DSA_QKV + IDX_HEADS * IDX_DIM + IDX_DIM]
DSA_IN_WIDTH = DSA_SPLITS[-1] + IDX_HEADS
ROPE_DIM = 64
BIG_SCORE = 1e30
FFN_HIDDEN = 2816
CONV_WIDTH = 3

kernel_name = "hybrid_diffattn_dsa_convffn_meta"


def rms_norm(x, g):
    xf = x.astype(jnp.float32)
    y = xf * lax.rsqrt(jnp.mean(xf * xf, axis=-1, keepdims=True) + RMS_EPS)
    return (y * g.astype(jnp.float32)).astype(x.dtype)


def rope_tables(T, dim):
    inv = ROPE_THETA ** (-jnp.arange(0, dim, 2, dtype=jnp.float32) / dim)
    ang = jnp.arange(T, dtype=jnp.float32)[:, None] * inv[None, :]
    return jnp.cos(ang), jnp.sin(ang)


def apply_rope(x, cos, sin):
    shape = (1, cos.shape[0]) + (1,) * (x.ndim - 3) + (cos.shape[1],)
    c = cos.reshape(shape)
    s = sin.reshape(shape)
    x1, x2 = jnp.split(x.astype(jnp.float32), 2, axis=-1)
    return jnp.concatenate([x1 * c - x2 * s, x2 * c + x1 * s], axis=-1).astype(x.dtype)


def sweep_blocks(fn, T):
    out = lax.map(fn, jnp.arange(T // BLOCK_Q) * BLOCK_Q)
    out = jnp.moveaxis(out, 0, 1)
    return out.reshape((out.shape[0], T) + out.shape[3:])


def diff_attention(h, w_qkv, lq1, lk1, lq2, lk2, subln, w_o, cos, sin, lambda_init):
    B, T, _ = h.shape
    q, k, v = jnp.split(h @ w_qkv, 3, axis=-1)
    q = apply_rope(q.reshape(B, T, DA_HEADS, 2, DA_HEAD_DIM), cos, sin) * (DA_HEAD_DIM ** -0.5)
    k = apply_rope(k.reshape(B, T, DA_HEADS, 2, DA_HEAD_DIM), cos, sin)
    v = v.reshape(B, T, DA_HEADS, 2 * DA_HEAD_DIM)
    f32 = jnp.float32
    lam = (jnp.exp(jnp.sum(lq1.astype(f32) * lk1.astype(f32)))
           - jnp.exp(jnp.sum(lq2.astype(f32) * lk2.astype(f32))) + lambda_init)
    k_pos = jnp.arange(T)

    def block(start):
        q_pos = start + jnp.arange(BLOCK_Q)
        qb = lax.dynamic_slice_in_dim(q, start, BLOCK_Q, axis=1)
        s = jnp.einsum('bqhcd,bkhcd->bhcqk', qb, k).astype(f32)
        s = jnp.where(k_pos[None, :] <= q_pos[:, None], s, -jnp.inf)
        p = jax.nn.softmax(s, axis=-1)
        a = p[:, :, 0] - lam * p[:, :, 1]
        return jnp.einsum('bhqk,bkhe->bqhe', a.astype(v.dtype), v)

    o = sweep_blocks(block, T)
    o = rms_norm(o, subln) * (1.0 - lambda_init)
    return o.reshape(B, T, DA_HEADS * 2 * DA_HEAD_DIM) @ w_o


def dsa_attention(h, w_in, idx_k_norm, w_o, cos, sin, n_keys):
    B, T, _ = h.shape
    q, k, v, qi, ki, wi = jnp.split(h @ w_in, DSA_SPLITS, axis=-1)
    q = apply_rope(q.reshape(B, T, DSA_HEADS, DSA_HEAD_DIM), cos, sin) * (DSA_HEAD_DIM ** -0.5)
    k = apply_rope(k.reshape(B, T, DSA_HEADS, DSA_HEAD_DIM), cos, sin)
    v = v.reshape(B, T, DSA_HEADS, DSA_HEAD_DIM)
    qi = apply_rope(qi.reshape(B, T, IDX_HEADS, IDX_DIM), cos, sin)
    ki = apply_rope(rms_norm(ki, idx_k_norm), cos, sin)
    wi = wi * (IDX_HEADS ** -0.5)
    topk = min(TOPK_MAX, n_keys // 4)
    k_pos = jnp.arange(T)
    f32 = jnp.float32
    gather = jax.vmap(lambda arr, idx: arr[idx])

    def block(start):
        q_pos = start + jnp.arange(BLOCK_Q)
        qb = lax.dynamic_slice_in_dim(q, start, BLOCK_Q, axis=1)
        qib = lax.dynamic_slice_in_dim(qi, start, BLOCK_Q, axis=1)
        wb = lax.dynamic_slice_in_dim(wi, start, BLOCK_Q, axis=1)
        raw = jnp.einsum('bqhd,bkd->bqhk', qib, ki).astype(f32) * (IDX_DIM ** -0.5)
        score = jnp.einsum('bqhk,bqh->bqk', jax.nn.relu(raw), wb.astype(f32))
        causal = k_pos[None, :] <= q_pos[:, None]
        score = jnp.where(causal & (k_pos < N_META)[None, :], BIG_SCORE, score)
        score = jnp.where(causal, score, -jnp.inf)
        top_val, top_idx = lax.top_k(score, topk)
        valid = top_val > -jnp.inf
        ks = gather(k, top_idx)
        vs = gather(v, top_idx)
        s = jnp.einsum('bqhd,bqjhd->bhqj', qb, ks).astype(f32)
        s = jnp.where(valid[:, None], s, -jnp.inf)
        p = jax.nn.softmax(s, axis=-1)
        return jnp.einsum('bhqj,bqjhd->bqhd', p.astype(vs.dtype), vs)

    o = sweep_blocks(block, T)
    return o.reshape(B, T, DSA_QKV) @ w_o


def conv_ffn(h, w_up, conv_w, conv_b, w_down):
    u = h @ w_up
    T = u.shape[1]
    up = jnp.pad(u, ((0, 0), (CONV_WIDTH - 1, 0), (0, 0)))
    c = conv_b + sum(conv_w[j] * up[:, j:j + T] for j in range(CONV_WIDTH))
    g, val = jnp.split(c, 2, axis=-1)
    return (jax.nn.silu(g) * val) @ w_down


def setup_inputs(seed: int = 0) -> dict:
    key = jax.random.key(seed)
    ks = iter(jax.random.split(key, 32))
    n_a = (DEPTH + 1) // 2
    n_b = DEPTH // 2
    D, F = D_MODEL, FFN_HIDDEN

    def nrm(shape, scale):
        return jax.random.normal(next(ks), shape, jnp.float32) * scale

    def gain(shape):
        return 1.0 + nrm(shape, 0.02)

    return {
        "x": nrm((BATCH, SEQ, D), 1.0),
        "meta_tokens": nrm((N_META, D), 1.0),
        "da_norm": gain((n_a, D)),
        "da_w_qkv": nrm((n_a, D, 3 * D), D ** -0.5),
        "da_lambda_q1": nrm((n_a, DA_HEAD_DIM), 0.1),
        "da_lambda_k1": nrm((n_a, DA_HEAD_DIM), 0.1),
        "da_lambda_q2": nrm((n_a, DA_HEAD_DIM), 0.1),
        "da_lambda_k2": nrm((n_a, DA_HEAD_DIM), 0.1),
        "da_subln": gain((n_a, 2 * DA_HEAD_DIM)),
        "da_w_o": nrm((n_a, DA_HEADS * 2 * DA_HEAD_DIM, D), D ** -0.5),
        "dsa_norm": gain((n_b, D)),
        "dsa_w_in": nrm((n_b, D, DSA_IN_WIDTH), D ** -0.5),
        "dsa_idx_k_norm": gain((n_b, IDX_DIM)),
        "dsa_w_o": nrm((n_b, DSA_QKV, D), DSA_QKV ** -0.5),
        "ffn_norm": gain((DEPTH, D)),
        "ffn_w_up": nrm((DEPTH, D, 2 * F), D ** -0.5),
        "ffn_conv_w": nrm((DEPTH, CONV_WIDTH, 2 * F), CONV_WIDTH ** -0.5),
        "ffn_conv_b": nrm((DEPTH, 2 * F), 0.02),
        "ffn_w_down": nrm((DEPTH, F, D), F ** -0.5),
        "final_norm": gain((D,)),
    }


def reference(x, meta_tokens, da_norm, da_w_qkv, da_lambda_q1, da_lambda_k1,
              da_lambda_q2, da_lambda_k2, da_subln, da_w_o, dsa_norm, dsa_w_in,
              dsa_idx_k_norm, dsa_w_o, ffn_norm, ffn_w_up, ffn_conv_w, ffn_conv_b,
              ffn_w_down, final_norm):
    B, L, D = x.shape
    T = L + N_META
    T_pad = ((T + BLOCK_Q - 1) // BLOCK_Q) * BLOCK_Q
    meta = jnp.broadcast_to(meta_tokens[None].astype(x.dtype), (B, N_META, D))
    h = jnp.concatenate([meta, x], axis=1)
    h = jnp.pad(h, ((0, 0), (0, T_pad - T), (0, 0)))
    cos, sin = rope_tables(T_pad, ROPE_DIM)
    for i in range(DEPTH):
        j = i // 2
        if i % 2 == 0:
            lambda_init = 0.8 - 0.6 * math.exp(-0.3 * i)
            h = h + diff_attention(rms_norm(h, da_norm[j]), da_w_qkv[j],
                                   da_lambda_q1[j], da_lambda_k1[j],
                                   da_lambda_q2[j], da_lambda_k2[j],
                                   da_subln[j], da_w_o[j], cos, sin, lambda_init)
        else:
            h = h + dsa_attention(rms_norm(h, dsa_norm[j]), dsa_w_in[j],
                                  dsa_idx_k_norm[j], dsa_w_o[j], cos, sin, L)
        h = h + conv_ffn(rms_norm(h, ffn_norm[i]), ffn_w_up[i], ffn_conv_w[i],
                         ffn_conv_b[i], ffn_w_down[i])
    h = rms_norm(h, final_norm)
    return h[:, N_META:N_META + L]
```

```cpp
#include <hip/hip_runtime.h>
#include <hip/hip_bf16.h>
#include <cstdio>
#include <cstdint>
#include <cmath>
namespace pg8 {
#define PG8_LAS __attribute__((address_space(3)))
typedef unsigned short bf16_t;
typedef short bf16x8 __attribute__((ext_vector_type(8)));
typedef float f32x4 __attribute__((ext_vector_type(4)));
typedef unsigned u32x4 __attribute__((ext_vector_type(4)));
constexpr int BM = 256, BK = 64, HALF = 128, HTB = HALF * BK * 2  , STAGE_BYTES = 8 * HTB, NXCD = 8, WGM = 8;

__host__ __device__ __forceinline__ int lds_byte(int r, int c) { const int st = (r >> 4) * 2 + (c >> 5), rr = r & 15, cc = c & 31, ob = rr * 64 + cc * 2; return st * 1024 + (ob ^ (((ob >> 9) & 1) << 5)); }
__host__ __device__ __forceinline__ void stage_rc(int b, int& R, int& C) { const int st = b / 1024, sb = b % 1024, swz = sb ^ (((sb >> 9) & 1) << 5); R = (st >> 1) * 16 + swz / 64; C = (st & 1) * 32 + (swz % 64) / 2; }
__host__ __device__ __forceinline__ int perm32(int rho) { const int n = rho >> 4, i = rho & 15; return 8 * (i >> 2) + 4 * n + (i & 3); }

__host__ __device__ __forceinline__ int arow(int pm) { return (pm >> 6) * 16640 + 16 + ((pm & 63) << 8); }
struct Unit { int pm, pn; };
struct Gemm { const bf16_t* A; const bf16_t* Bt; int M, N, K; };

struct StaticOrder {
    int nM, nN, nwg, G, c;
    __host__ __device__ void init(int M, int N, int G_, int c_) { nM = M / BM; nN = N / BM; nwg = nM * nN; G = G_; c = c_; }
    __host__ __device__ bool next(int i, Unit& u) const {
        const long L = (long)i * G + c; if (L >= nwg) return false;
        int wgid = (int)L; { const int q = nwg / NXCD, r = nwg % NXCD, xcd = wgid % NXCD, off = wgid / NXCD; wgid = (xcd < r ? xcd * (q + 1) : r * (q + 1) + (xcd - r) * q) + off; }
        const int nig = WGM * nN, gid = wgid / nig, fm = gid * WGM, gsz = (nM - fm) < WGM ? (nM - fm) : WGM;
        u.pm = fm + ((wgid % nig) % gsz); u.pn = (wgid % nig) / gsz; return true;
    }
    __device__ __forceinline__ void a_ready(const Unit&) const {}
    __device__ __forceinline__ void done(const Unit&) const {}
};
__device__ __forceinline__ unsigned cvt_pk_bf16(float lo, float hi) { unsigned r; asm volatile("v_cvt_pk_bf16_f32 %0, %1, %2" : "=v"(r) : "v"(lo), "v"(hi)); return r; }
template <class Epi, class Sched, bool ALIGN_EPI = false, bool SP2 = false>
__device__ __forceinline__ void gemm_phase(PG8_LAS unsigned char* lds, const Gemm g, const Sched& S, const Epi& E) {
    int tid_ = threadIdx.x; asm volatile("" : "+v"(tid_));
    const int tid = tid_, wid = __builtin_amdgcn_readfirstlane(tid >> 6), lane = tid & 63, wr = wid >> 2, wc = wid & 3, fr = lane & 15, fq = lane >> 4;
    const int K = g.K, nt = K / BK;
    unsigned voffA[2], voffB[2];
#pragma unroll
    for (int i = 0; i < 2; ++i) { int R, C; stage_rc(tid * 16 + i * 8192, R, C); const int Rb = Epi::PERM ? ((R & ~31) + perm32(R & 31)) : R;
        voffA[i] = (unsigned)(R * K + C) * 2u; voffB[i] = (unsigned)(Rb * K + C) * 2u; }
    const size_t kstep = (size_t)(BK * 2);
    const size_t hstep = (size_t)HALF * K * 2;
    const size_t tstep = 2 * hstep;
    const unsigned ldsw = (unsigned)wid * 1024u;
    const int aoff = lds_byte(wr * 64 + fr, fq * 8), boff = lds_byte(wc * 32 + fr, fq * 8);
#define PG8_SA(b, h) (((b) * 2 + (h)) * HTB)
#define PG8_SB(b, h) ((4 + (b) * 2 + (h)) * HTB)
#define PG8_STAGE(bufoff, gbase, voff) do { _Pragma("unroll") for (int _i = 0; _i < 2; ++_i) \
        __builtin_amdgcn_global_load_lds((const unsigned*)((const char*)(gbase) + (voff)[_i]), (PG8_LAS unsigned*)(lds + (bufoff) + ldsw + _i * 8192), 16, 0, 0); } while (0)
#define PG8_LDA(dst, b, h) do { _Pragma("unroll") for (int m = 0; m < 4; ++m) _Pragma("unroll") for (int k = 0; k < 2; ++k) dst[m][k] = *(const PG8_LAS bf16x8*)(lds + PG8_SA(b, h) + aoff + m * 2048 + k * 1024); } while (0)
#define PG8_LDB(dst, b, h) do { _Pragma("unroll") for (int n = 0; n < 2; ++n) _Pragma("unroll") for (int k = 0; k < 2; ++k) dst[n][k] = *(const PG8_LAS bf16x8*)(lds + PG8_SB(b, h) + boff + n * 2048 + k * 1024); } while (0)
#define PG8_MMA(ai, bj, At, Bt) do { __builtin_amdgcn_s_setprio(1); _Pragma("unroll") for (int m = 0; m < 4; ++m) _Pragma("unroll") for (int n = 0; n < 2; ++n) _Pragma("unroll") for (int k = 0; k < 2; ++k) \
        acc[ai][bj][m][n] = __builtin_amdgcn_mfma_f32_16x16x32_bf16(Bt[n][k], At[m][k], acc[ai][bj][m][n], 0, 0, 0); __builtin_amdgcn_s_setprio(0); } while (0)
#define PG8_WAIT_V(n) asm volatile("s_waitcnt vmcnt(" #n ")" ::: "memory")
#define PG8_WAIT_L(n) asm volatile("s_waitcnt lgkmcnt(" #n ")" ::: "memory")
#define PG8_BAR __builtin_amdgcn_s_barrier()
#define PG8_SCHED __builtin_amdgcn_sched_barrier(0)
    Unit cur, nxt; int ui = 0;
    if (!S.next(0, cur)) return;
    f32x4 acc[2][2][4][2]; float zf_ = 0.f; asm volatile("" : "+v"(zf_));
#pragma unroll
    for (int a = 0; a < 2; ++a)
#pragma unroll
        for (int b = 0; b < 2; ++b)
#pragma unroll
            for (int m = 0; m < 4; ++m)
#pragma unroll
                for (int n = 0; n < 2; ++n) acc[a][b][m][n] = (f32x4){zf_, zf_, zf_, zf_};
    bf16x8 At[4][2], B0[2][2], B1[2][2];
    const char* cA = (const char*)g.A + (size_t)arow(cur.pm) * K * 2; const char* cB = (const char*)g.Bt + (size_t)cur.pn * tstep;
    S.a_ready(cur);
    if constexpr (SP2) {
        PG8_STAGE(PG8_SB(0, 0), cB, voffB); PG8_STAGE(PG8_SB(0, 1), cB + hstep, voffB); PG8_STAGE(PG8_SA(0, 0), cA, voffA); PG8_STAGE(PG8_SA(0, 1), cA + hstep, voffA);
        if (wr == 1) PG8_BAR;
        PG8_WAIT_V(2); PG8_BAR;
        PG8_STAGE(PG8_SB(1, 0), cB + kstep, voffB); PG8_STAGE(PG8_SA(1, 0), cA + kstep, voffA); PG8_STAGE(PG8_SB(1, 1), cB + hstep + kstep, voffB);
        PG8_WAIT_V(6); PG8_BAR;
    } else {
        PG8_STAGE(PG8_SB(0, 0), cB, voffB); PG8_STAGE(PG8_SA(0, 0), cA, voffA); PG8_STAGE(PG8_SB(0, 1), cB + hstep, voffB); PG8_STAGE(PG8_SA(0, 1), cA + hstep, voffA);
        if (wr == 1) PG8_BAR;
        PG8_WAIT_V(4); PG8_BAR;
        PG8_STAGE(PG8_SB(1, 0), cB + kstep, voffB); PG8_STAGE(PG8_SA(1, 0), cA + kstep, voffA); PG8_STAGE(PG8_SB(1, 1), cB + hstep + kstep, voffB);
        PG8_WAIT_V(6); PG8_BAR;
    }
    for (;;) {
        const bool has_next = S.next(ui + 1, nxt);
        const char* nA = has_next ? (const char*)g.A + (size_t)arow(nxt.pm) * K * 2 : cA; const char* nB = has_next ? (const char*)g.Bt + (size_t)nxt.pn * tstep : cB;
        for (int t = 0; t < nt; t += 2) {
            const bool last = (t == nt - 2);
            const char* a1 = cA + (size_t)(t + 1) * kstep;
            const char* a2 = last ? nA : cA + (size_t)(t + 2) * kstep; const char* b2 = last ? nB : cB + (size_t)(t + 2) * kstep;
            const char* a3 = a2 + kstep; const char* b3 = b2 + kstep;
            if (last && has_next) S.a_ready(nxt);
            if constexpr (SP2) {
            PG8_LDB(B0, 0, 0); PG8_LDB(B1, 0, 1); PG8_SCHED; PG8_LDA(At, 0, 0); PG8_STAGE(PG8_SA(1, 1), a1 + hstep, voffA);
            PG8_WAIT_V(8); PG8_WAIT_L(0); PG8_BAR; PG8_MMA(0, 0, At, B0); PG8_MMA(0, 1, At, B1); PG8_BAR; PG8_SCHED;
            PG8_LDA(At, 0, 1); PG8_STAGE(PG8_SB(0, 0), b2, voffB); PG8_STAGE(PG8_SB(0, 1), b2 + hstep, voffB); PG8_STAGE(PG8_SA(0, 0), a2, voffA);
            PG8_WAIT_V(8); PG8_WAIT_L(0); PG8_BAR; PG8_MMA(1, 0, At, B0); PG8_MMA(1, 1, At, B1); PG8_BAR; PG8_SCHED;
            PG8_LDB(B0, 1, 0); PG8_LDB(B1, 1, 1); PG8_SCHED; PG8_LDA(At, 1, 0); PG8_STAGE(PG8_SA(0, 1), a2 + hstep, voffA);
            PG8_WAIT_V(8); PG8_WAIT_L(0); PG8_BAR; PG8_MMA(0, 0, At, B0); PG8_MMA(0, 1, At, B1); PG8_BAR; PG8_SCHED;
            PG8_LDA(At, 1, 1); PG8_STAGE(PG8_SB(1, 0), b3, voffB); PG8_STAGE(PG8_SB(1, 1), b3 + hstep, voffB); PG8_STAGE(PG8_SA(1, 0), a3, voffA);
            PG8_WAIT_V(8); PG8_WAIT_L(0); PG8_BAR; PG8_MMA(1, 0, At, B0); PG8_MMA(1, 1, At, B1); PG8_BAR; PG8_SCHED;
            } else {
            PG8_LDB(B0, 0, 0); PG8_SCHED; PG8_LDA(At, 0, 0); PG8_STAGE(PG8_SA(1, 1), a1 + hstep, voffA);
            PG8_WAIT_L(8); PG8_BAR; PG8_WAIT_L(0); PG8_MMA(0, 0, At, B0); PG8_BAR; PG8_SCHED;
            PG8_LDB(B1, 0, 1); PG8_STAGE(PG8_SB(0, 0), b2, voffB);
            PG8_BAR; PG8_WAIT_L(0); PG8_MMA(0, 1, At, B1); PG8_BAR;
            PG8_LDA(At, 0, 1); PG8_STAGE(PG8_SA(0, 0), a2, voffA);
            PG8_BAR; PG8_WAIT_L(0); PG8_MMA(1, 0, At, B0); PG8_BAR; PG8_SCHED;
            PG8_STAGE(PG8_SB(0, 1), b2 + hstep, voffB);
            PG8_WAIT_V(6); PG8_BAR; PG8_MMA(1, 1, At, B1); PG8_BAR;
            PG8_LDB(B0, 1, 0); PG8_SCHED; PG8_LDA(At, 1, 0); PG8_STAGE(PG8_SA(0, 1), a2 + hstep, voffA);
            PG8_WAIT_L(8); PG8_BAR; PG8_WAIT_L(0); PG8_MMA(0, 0, At, B0); PG8_BAR; PG8_SCHED;
            PG8_LDB(B1, 1, 1); PG8_STAGE(PG8_SB(1, 0), b3, voffB);
            PG8_BAR; PG8_WAIT_L(0); PG8_MMA(0, 1, At, B1); PG8_BAR;
            PG8_LDA(At, 1, 1); PG8_STAGE(PG8_SA(1, 0), a3, voffA);
            PG8_BAR; PG8_WAIT_L(0); PG8_MMA(1, 0, At, B0); PG8_BAR; PG8_SCHED;
            PG8_STAGE(PG8_SB(1, 1), b3 + hstep, voffB);
            PG8_WAIT_V(6); PG8_BAR; PG8_MMA(1, 1, At, B1); PG8_BAR;
            }
        }
        if constexpr (ALIGN_EPI) { if (wr == 0) PG8_BAR; }
        if constexpr (!Epi::AFTER_DRAIN) { E(acc, cur, wr, wc, fr, fq); S.done(cur); }
        if (!has_next) break;
#pragma unroll
        for (int a = 0; a < 2; ++a)
#pragma unroll
            for (int b = 0; b < 2; ++b)
#pragma unroll
                for (int m = 0; m < 4; ++m)
#pragma unroll
                    for (int n = 0; n < 2; ++n) acc[a][b][m][n] = (f32x4){zf_, zf_, zf_, zf_};
        cur = nxt; cA = nA; cB = nB; ++ui;
        if constexpr (ALIGN_EPI) { if (wr == 1) PG8_BAR; }
    }
    PG8_WAIT_V(0);
    if constexpr (!ALIGN_EPI) { if (wr == 0) PG8_BAR; }
    PG8_BAR;
    if constexpr (Epi::AFTER_DRAIN) { E.fused(acc, cur, wr, wc, fr, fq, lds, wid, lane); S.done(cur); }
#undef PG8_SA
#undef PG8_SB
#undef PG8_STAGE
#undef PG8_LDA
#undef PG8_LDB
#undef PG8_MMA
#undef PG8_WAIT_V
#undef PG8_WAIT_L
#undef PG8_BAR
#undef PG8_SCHED
}
}

namespace attn_body {
using bf16=__hip_bfloat16;
using bf16x8=__attribute__((ext_vector_type(8)))short;
using s16x4=__attribute__((ext_vector_type(4)))short;
using f32x16=__attribute__((ext_vector_type(16)))float;
using u32x4=__attribute__((ext_vector_type(4)))unsigned;
constexpr int SEQ=16640,TREAL=16400,D=64,DM=1024;
constexpr int NW=8,QBLK=32,QB=QBLK*NW,KVBLK=64,NQB=SEQ/QB;
constexpr int ATTN_PITCH=DM, ATTN_UNIT_ROWS=QB;
__device__ __forceinline__ int crow(int r,int hi){return (r&3)+8*(r>>2)+4*hi;}
#define SBAR() __builtin_amdgcn_sched_barrier(0)
typedef unsigned u32x2 __attribute__((ext_vector_type(2)));
__device__ __forceinline__ void mmask(f32x16&p0,f32x16&p1,unsigned w0,unsigned w1,int hi){
  const float NEG=-INFINITY; const unsigned a=w0>>(4*hi), b=w1>>(4*hi);
  #pragma unroll
  for(int r=0;r<16;++r){const int c=(r&3)+8*(r>>2); if(!((a>>c)&1u))p0[r]=NEG; if(!((b>>c)&1u))p1[r]=NEG;}
}
__device__ __forceinline__ void cmask(f32x16&p0,f32x16&p1,int jb,int qrel,int hi){
  const float NEG=-INFINITY; int kb=64*jb+4*hi;
  #pragma unroll
  for(int r=0;r<16;++r){int kv=kb+(r&3)+8*(r>>2); if(kv>qrel)p0[r]=NEG; if(kv+32>qrel)p1[r]=NEG;}
}

constexpr int NSLOT=3, SLOTB=8192;
constexpr int LDS_K=0, LDS_V=NSLOT*SLOTB, LDS_WS=2*NSLOT*SLOTB, LDS_OST=LDS_WS+NW*64*4, LDS_MK=LDS_OST+NW*4096, LDS_BYTES=LDS_MK+NW*2048;
constexpr float C2=0.125f*1.4426950408889634f;
__device__ __forceinline__ void glds16(const void*gsrc,unsigned lds_dst){unsigned keep;
  asm volatile("s_mov_b32 %0, m0\n\ts_mov_b32 m0, %2\n\ts_nop 0\n\tglobal_load_lds_dwordx4 %1, off\n\ts_mov_b32 m0, %0":"=&s"(keep):"v"(gsrc),"s"(lds_dst):"memory");}
__device__ __forceinline__ float max3f(float a,float b,float c){float r;asm("v_max3_f32 %0, %1, %2, %3":"=v"(r):"v"(a),"v"(b),"v"(c));return r;}
__device__ __forceinline__ float max2f(float a,float b){float r;asm("v_max_f32_e32 %0, %1, %2":"=v"(r):"v"(a),"v"(b));return r;}
__device__ __forceinline__ float fadd_s(float a,float b){float r;asm("v_add_f32_e32 %0, %1, %2":"=v"(r):"v"(a),"v"(b));return r;}
__device__ __forceinline__ float fsub_s(float a,float b){float r;asm("v_sub_f32_e32 %0, %1, %2":"=v"(r):"v"(a),"v"(b));return r;}
typedef float f32x2_t __attribute__((ext_vector_type(2))); typedef __bf16 bf16x2_t __attribute__((ext_vector_type(2)));
__device__ __forceinline__ unsigned cvtpk_s(float lo,float hi){f32x2_t v={lo,hi};bf16x2_t b=__builtin_convertvector(v,bf16x2_t);return __builtin_bit_cast(unsigned,b);}
#define WAIT_BAR(N) asm volatile("s_waitcnt vmcnt(" #N ") lgkmcnt(0)\n\ts_barrier":::"memory")

__device__ __forceinline__ void qkt(f32x16&p0,f32x16&p1,const char*Kslot,const bf16x8*qr,const f32x16&negm,int r32,int hi){
  const char*kb=Kslot+hi*1024+r32*16;
  #pragma unroll
  for(int d0=0;d0<4;++d0){
    const bf16x8 b0=*reinterpret_cast<const bf16x8*>(kb+d0*2048);
    const bf16x8 b1=*reinterpret_cast<const bf16x8*>(kb+d0*2048+512);
    if(d0==0){p0=__builtin_amdgcn_mfma_f32_32x32x16_bf16(b0,qr[0],negm,0,0,0);p1=__builtin_amdgcn_mfma_f32_32x32x16_bf16(b1,qr[0],negm,0,0,0);}
    else{p0=__builtin_amdgcn_mfma_f32_32x32x16_bf16(b0,qr[d0],p0,0,0,0);p1=__builtin_amdgcn_mfma_f32_32x32x16_bf16(b1,qr[d0],p1,0,0,0);}}
}
typedef __attribute__((address_space(3))) const char* lds_cptr;
typedef short v4i16_t __attribute__((ext_vector_type(4)));
__device__ __forceinline__ void kload8(bf16x8*kf,lds_cptr kp){
  kf[0]=*(const __attribute__((address_space(3))) bf16x8*)(kp);      kf[1]=*(const __attribute__((address_space(3))) bf16x8*)(kp+512);
  kf[2]=*(const __attribute__((address_space(3))) bf16x8*)(kp+2048); kf[3]=*(const __attribute__((address_space(3))) bf16x8*)(kp+2560);
  kf[4]=*(const __attribute__((address_space(3))) bf16x8*)(kp+4096); kf[5]=*(const __attribute__((address_space(3))) bf16x8*)(kp+4608);
  kf[6]=*(const __attribute__((address_space(3))) bf16x8*)(kp+6144); kf[7]=*(const __attribute__((address_space(3))) bf16x8*)(kp+6656);
}
__device__ __forceinline__ void kload2(bf16x8*kf,lds_cptr kp,int j){ kf[2*j]=*(const __attribute__((address_space(3))) bf16x8*)(kp+j*2048); kf[2*j+1]=*(const __attribute__((address_space(3))) bf16x8*)(kp+j*2048+512); }
__device__ __forceinline__ s16x4 vtr(lds_cptr p){ return __builtin_bit_cast(s16x4,__builtin_amdgcn_ds_read_tr16_b64_v4i16((__attribute__((address_space(3))) v4i16_t*)p)); }
__device__ __forceinline__ float rowmax(const f32x16&p0,const f32x16&p1){
  float a=max3f(p0[0],p0[1],p1[0]),b=max3f(p0[2],p0[3],p1[1]);a=max3f(a,p1[2],p1[3]);
  #pragma unroll
  for(int r=4;r<16;r+=4){a=max3f(a,p0[r],p0[r+1]);b=max3f(b,p0[r+2],p0[r+3]);a=max3f(a,p1[r],p1[r+1]);b=max3f(b,p1[r+2],p1[r+3]);}
  const float m=max2f(a,b);
  auto rr=__builtin_amdgcn_permlane32_swap(__float_as_uint(m),__float_as_uint(m),false,false);
  return max2f(__uint_as_float(rr[0]),__uint_as_float(rr[1]));
}
__device__ __forceinline__ void pv(f32x16*o,int vb,bf16x8 pa0,bf16x8 pa1,bf16x8 pa2,bf16x8 pa3){
  #pragma unroll
  for(int d0=0;d0<2;++d0){s16x4 lo[4],hi[4];
    #pragma unroll
    for(int ks=0;ks<4;++ks){
      asm volatile("ds_read_b64_tr_b16 %0,%1 offset:%c2":"=&v"(lo[ks]):"v"(vb),"i"(d0*4096+ks*1024):"memory");
      asm volatile("ds_read_b64_tr_b16 %0,%1 offset:%c2":"=&v"(hi[ks]):"v"(vb),"i"(d0*4096+ks*1024+512):"memory");}
    asm volatile("s_waitcnt lgkmcnt(0)":::"memory");SBAR();
    #define PK(k) (bf16x8){lo[k][0],lo[k][1],lo[k][2],lo[k][3],hi[k][0],hi[k][1],hi[k][2],hi[k][3]}
    o[d0]=__builtin_amdgcn_mfma_f32_32x32x16_bf16(pa0,PK(0),o[d0],0,0,0);
    o[d0]=__builtin_amdgcn_mfma_f32_32x32x16_bf16(pa1,PK(1),o[d0],0,0,0);
    o[d0]=__builtin_amdgcn_mfma_f32_32x32x16_bf16(pa2,PK(2),o[d0],0,0,0);
    o[d0]=__builtin_amdgcn_mfma_f32_32x32x16_bf16(pa3,PK(3),o[d0],0,0,0);
    #undef PK
  }
}

#ifndef ATTN_STORE16
#define ATTN_STORE16(p,v) (*(u32x4*)(p)=(v))
#endif
template<int THRL,bool MASKED> __device__ __forceinline__ void attn_unit(int b,int hq,int hv,int qb,const bf16*Q,const bf16*__restrict__ K,const bf16*__restrict__ V,bf16*O,const unsigned*__restrict__ MK,char*shm){
  int tid_=threadIdx.x; asm volatile("":"+v"(tid_));
  const int tid=tid_,lane=tid&63,r32=lane&31,hi=lane>>5; const int wid=__builtin_amdgcn_readfirstlane(tid>>6);
  const long rowbase=(long)b*SEQ; const int q0=qb*QB;
  const bf16*Qw=Q+(rowbase+q0+wid*QBLK)*DM+hq*D;
  const bf16*Kh=K+rowbase*DM+hq*D,*Vh=V+rowbase*DM+hv*D;
  const unsigned lds0=(unsigned)(uintptr_t)shm;
  float*wsf=(float*)(shm+LDS_WS)+wid*64;
  const bf16*ksrc=Kh+(long)lane*DM+wid*8;
  const bf16*vsrc=Vh+(long)(16*(wid&3)+(lane>>2))*DM+(wid>>2)*32+(lane&3)*8;
  const unsigned kdst=lds0+LDS_K+wid*1024, vdst=lds0+LDS_V+wid*1024;
  #define DMA_K(t,slot) glds16(ksrc+(long)(t)*KVBLK*DM,(unsigned)__builtin_amdgcn_readfirstlane(kdst+(slot)))
  #define DMA_V(t,slot) glds16(vsrc+(long)(t)*KVBLK*DM,(unsigned)__builtin_amdgcn_readfirstlane(vdst+(slot)))
  const int vb0=(int)(lds0+LDS_V)+((lane>>4)&1)*32+(lane&3)*8+(4*hi+((lane&15)>>2))*64;
  const char*Kbase=shm+LDS_K; bf16x8 kf[8];
  const lds_cptr shm3=(lds_cptr)shm; const lds_cptr kp0=shm3+LDS_K+hi*1024+r32*16; const lds_cptr vp0=shm3+LDS_V+((lane>>4)&1)*32+(lane&3)*8+(4*hi+((lane&15)>>2))*64;
  const int NT=(q0+QB)/KVBLK;
  const unsigned*msrc=MK+((rowbase+q0+wid*QBLK+r32)*520+4*hi); const unsigned mdst=lds0+LDS_MK+wid*2048; const lds_cptr mp0=(lds_cptr)shm+LDS_MK+wid*2048+r32*16;
  #define DMA_M(j) glds16(msrc+8*(j),(unsigned)__builtin_amdgcn_readfirstlane(mdst+(((j)&1)*1024)))
  #define MMASK(P0,P1,t) do{ if(MASKED){ const u32x2 mw_=*(const __attribute__((address_space(3))) u32x2*)(mp0+((((t)>>2)&1)*1024+(((t)>>1)&1)*512+((t)&1)*8)); mmask(P0,P1,mw_.x,mw_.y,hi);} }while(0)
  if(MASKED){DMA_M(0);}
  DMA_K(0,0);DMA_V(0,0);DMA_K(1,SLOTB);
  bf16x8 qr[4];
  #pragma unroll
  for(int d0=0;d0<4;++d0)qr[d0]=*reinterpret_cast<const bf16x8*>(&Qw[(long)r32*DM+d0*16+hi*8]);
  float mhat=0.f,l_reg=0.f;f32x16 o[2];o[0]=f32x16{};o[1]=f32x16{};f32x16 negm=f32x16{};asm volatile("":"+v"(negm));
  const int qrel=wid*QBLK+r32;
  #define CMASK(P0,P1,t) do{ if(!MASKED){int jb_=(t)-(NT-4); if(jb_>=0)cmask(P0,P1,jb_,qrel,hi);} MMASK(P0,P1,t); }while(0)
  bool resc=false;
  #define START(P0,P1) do{ const float rm=rowmax(P0,P1); resc=false; \
    { const float dl=rm; mhat=fadd_s(mhat,dl); \
      _Pragma("unroll") for(int r=0;r<16;++r){P0[r]=fsub_s(P0[r],dl);P1[r]=fsub_s(P1[r],dl);} \
      _Pragma("unroll") for(int r=0;r<16;++r)negm[r]=-mhat; asm volatile("":"+v"(negm)); } \
    _Pragma("unroll") for(int r=0;r<16;++r)P0[r]=__builtin_amdgcn_exp2f(P0[r]); }while(0)
  #define RESC() do{ if(resc){ asm volatile("s_waitcnt lgkmcnt(0)":::"memory"); \
      _Pragma("unroll") for(int d_=0;d_<2;++d_) _Pragma("unroll") for(int r=0;r<16;++r)o[d_][r]*=wsf[crow(r,hi)]; } }while(0)
  f32x16 pA0,pA1,pB0,pB1;
  int sl_prev=0,sl_cur=0,sl_next=SLOTB;
  #define ROT() do{sl_prev=sl_cur;sl_cur=sl_next;sl_next=(sl_next==(NSLOT-1)*SLOTB)?0:sl_next+SLOTB;}while(0)
  DMA_K(2,2*SLOTB);
  WAIT_BAR(3);
  qkt(pA0,pA1,Kbase,qr,negm,r32,hi);asm volatile("s_nop 15\n\ts_nop 7":"+v"(pA0),"+v"(pA1));CMASK(pA0,pA1,0);
  START(pA0,pA1);
  _Pragma("unroll") for(int r=0;r<16;++r)pA1[r]=__builtin_amdgcn_exp2f(pA1[r]);
  WAIT_BAR(0);
  DMA_K(3,0);DMA_V(1,SLOTB);
  ROT();
  kload8(kf,kp0+sl_cur);
  WAIT_BAR(2);
  s16x4 vlo[8],vhi[8]; u32x4 pw0,pw1,pw2,pw3;
  #define PKW(P,B) cvtpk_s(P[B],P[B+1])
  #define PAF(k) __builtin_bit_cast(bf16x8,pw##k)
  #define VFR(i) (bf16x8){vlo[i][0],vlo[i][1],vlo[i][2],vlo[i][3],vhi[i][0],vhi[i][1],vhi[i][2],vhi[i][3]}
  #define PIN(x) asm volatile("":"+v"(x))
  #define MX3(a,b,c) __builtin_fmaxf(__builtin_fmaxf((a),(b)),(c))
  #define GAPA(MF,A0,A1,A2,A3,W0,W1,PW) do{ MF; sacc+=A0; sacc+=A1; sacc+=A2; sacc+=A3; PIN(sacc); W0; W1; PIN(PW); SBAR(); }while(0)
  #define EX(v) __builtin_amdgcn_exp2f(v)
  #define GAPB(MF,X,B) do{ MF; X[B]=EX(X[B]); X[B+1]=EX(X[B+1]); X[B+2]=EX(X[B+2]); X[B+3]=EX(X[B+3]); PIN(X); SBAR(); }while(0)
  #define VRD(i) do{ vlo[i]=vtr(vp_+(((i)>>2)*4096+((i)&3)*1024)); vhi[i]=vtr(vp_+(((i)>>2)*4096+((i)&3)*1024+512)); }while(0)
  #define KRD(G,j) do{ if(G){ kload2(kf,kp0+sl_next,j); SBAR(); } }while(0)
  #define STEP(C0,C1,P0,P1,t,GK,GV,GL) do{ SBAR(); \
    const lds_cptr vp_=vp0+sl_prev; \
    VRD(0); SBAR(); float sacc=(P0[0]+P0[1]); \
    GAPA(C0=__builtin_amdgcn_mfma_f32_32x32x16_bf16(kf[0],qr[0],negm,0,0,0), P0[2],P0[3],P0[4],P0[5],     pw0[0]=PKW(P0,0), pw0[1]=PKW(P0,2), pw0); \
    VRD(4); SBAR(); GAPA(C1=__builtin_amdgcn_mfma_f32_32x32x16_bf16(kf[1],qr[0],negm,0,0,0), P0[6],P0[7],P0[8],P0[9],     pw0[2]=PKW(P0,4), pw0[3]=PKW(P0,6), pw0); \
    VRD(1); SBAR(); GAPA(C0=__builtin_amdgcn_mfma_f32_32x32x16_bf16(kf[2],qr[1],C0,0,0,0),   P0[10],P0[11],P0[12],P0[13], pw1[0]=PKW(P0,8), pw1[1]=PKW(P0,10), pw1); \
    VRD(5); SBAR(); GAPA(C1=__builtin_amdgcn_mfma_f32_32x32x16_bf16(kf[3],qr[1],C1,0,0,0),   P0[14],P0[15],P1[0],P1[1],   pw1[2]=PKW(P0,12),pw1[3]=PKW(P0,14), pw1); \
    VRD(2); SBAR(); GAPA(C0=__builtin_amdgcn_mfma_f32_32x32x16_bf16(kf[4],qr[2],C0,0,0,0),   P1[2],P1[3],P1[4],P1[5],     pw2[0]=PKW(P1,0), pw2[1]=PKW(P1,2), pw2); \
    VRD(6); SBAR(); GAPA(C1=__builtin_amdgcn_mfma_f32_32x32x16_bf16(kf[5],qr[2],C1,0,0,0),   P1[6],P1[7],P1[8],P1[9],     pw2[2]=PKW(P1,4), pw2[3]=PKW(P1,6), pw2); \
    VRD(3); SBAR(); GAPA(C0=__builtin_amdgcn_mfma_f32_32x32x16_bf16(kf[6],qr[3],C0,0,0,0),   P1[10],P1[11],P1[12],P1[13], pw3[0]=PKW(P1,8), pw3[1]=PKW(P1,10), pw3); \
    VRD(7); SBAR(); GAPA(C1=__builtin_amdgcn_mfma_f32_32x32x16_bf16(kf[7],qr[3],C1,0,0,0),   P1[14],P1[15],0.f,0.f,       pw3[2]=PKW(P1,12),pw3[3]=PKW(P1,14), pw3); \
    l_reg+=sacc; \
    if(MASKED&&(((t)&3)==2)&&((t)+2<NT)){DMA_M(((t)+2)>>2);} if(GK){DMA_K((t)+3,sl_cur);} if(GV){DMA_V((t)+1,sl_next);} \
    CMASK(C0,C1,t); \
    { float a=MX3(C0[0],C0[1],C1[0]),b=MX3(C0[2],C0[3],C1[1]); a=MX3(a,C1[2],C1[3]); \
      _Pragma("unroll") for(int r=4;r<16;r+=4){a=MX3(a,C0[r],C0[r+1]);b=MX3(b,C0[r+2],C0[r+3]);a=MX3(a,C1[r],C1[r+1]);b=MX3(b,C1[r+2],C1[r+3]);} \
      float rm=__builtin_fmaxf(a,b); { auto rr=__builtin_amdgcn_permlane32_swap(__float_as_uint(rm),__float_as_uint(rm),false,false); rm=__builtin_fmaxf(__uint_as_float(rr[0]),__uint_as_float(rr[1])); } \
      resc=false; \
      if(__builtin_expect(__any(rm>(float)THRL),0)){ const float dl=__builtin_fmaxf(rm,0.f); mhat+=dl; \
        _Pragma("unroll") for(int r=0;r<16;++r){C0[r]-=dl;C1[r]-=dl;} \
        _Pragma("unroll") for(int r=0;r<16;++r)negm[r]=-mhat; asm volatile("":"+v"(negm)); \
        const float f=__builtin_amdgcn_exp2f(-dl); l_reg*=f; if(hi==0)wsf[r32]=f; resc=true; } } \
    SBAR(); \
    GAPB(o[0]=__builtin_amdgcn_mfma_f32_32x32x16_bf16(PAF(0),VFR(0),o[0],0,0,0), C0,0); \
    GAPB(o[1]=__builtin_amdgcn_mfma_f32_32x32x16_bf16(PAF(0),VFR(4),o[1],0,0,0), C0,4); \
    KRD(GL,0); GAPB(o[0]=__builtin_amdgcn_mfma_f32_32x32x16_bf16(PAF(1),VFR(1),o[0],0,0,0), C0,8); \
    KRD(GL,1); GAPB(o[1]=__builtin_amdgcn_mfma_f32_32x32x16_bf16(PAF(1),VFR(5),o[1],0,0,0), C0,12); \
    KRD(GL,2); GAPB(o[0]=__builtin_amdgcn_mfma_f32_32x32x16_bf16(PAF(2),VFR(2),o[0],0,0,0), C1,0); \
    KRD(GL,3); GAPB(o[1]=__builtin_amdgcn_mfma_f32_32x32x16_bf16(PAF(2),VFR(6),o[1],0,0,0), C1,4); \
    GAPB(o[0]=__builtin_amdgcn_mfma_f32_32x32x16_bf16(PAF(3),VFR(3),o[0],0,0,0), C1,8); \
    GAPB(o[1]=__builtin_amdgcn_mfma_f32_32x32x16_bf16(PAF(3),VFR(7),o[1],0,0,0), C1,12); \
    }while(0)
  int t=1;
  #undef CMASK
  #define CMASK(P0,P1,t) MMASK(P0,P1,t)
  for(;t+5<NT;t+=2){
    STEP(pB0,pB1,pA0,pA1,t,true,true,true);     WAIT_BAR(2); RESC(); ROT();
    STEP(pA0,pA1,pB0,pB1,t+1,true,true,true);   WAIT_BAR(2); RESC(); ROT();
  }
  #undef CMASK
  #define CMASK(P0,P1,t) do{ if(!MASKED){int jb_=(t)-(NT-4); if(jb_>=0)cmask(P0,P1,jb_,qrel,hi);} MMASK(P0,P1,t); }while(0)
  #define ENDW(tt) do{ if((tt)+3<NT){WAIT_BAR(2);} else if((tt)+2<NT){WAIT_BAR(1);} else {WAIT_BAR(0);} }while(0)
  for(;t+1<NT;t+=2){
    STEP(pB0,pB1,pA0,pA1,t,(t+3<NT),(t+1<NT),(t+1<NT));       ENDW(t);   RESC(); ROT();
    STEP(pA0,pA1,pB0,pB1,t+1,(t+4<NT),(t+2<NT),(t+2<NT));     ENDW(t+1); RESC(); ROT();
  }
  STEP(pB0,pB1,pA0,pA1,NT-1,false,false,false); RESC();
  { float sacc=pB0[0]+pB0[1]; _Pragma("unroll") for(int r=2;r<16;++r)sacc+=pB0[r]; _Pragma("unroll") for(int r=0;r<16;++r)sacc+=pB1[r]; l_reg+=sacc;
    pw0=(u32x4){PKW(pB0,0),PKW(pB0,2),PKW(pB0,4),PKW(pB0,6)};pw1=(u32x4){PKW(pB0,8),PKW(pB0,10),PKW(pB0,12),PKW(pB0,14)};pw2=(u32x4){PKW(pB1,0),PKW(pB1,2),PKW(pB1,4),PKW(pB1,6)};pw3=(u32x4){PKW(pB1,8),PKW(pB1,10),PKW(pB1,12),PKW(pB1,14)};
    SBAR(); pv(o,vb0+sl_cur,PAF(0),PAF(1),PAF(2),PAF(3)); }
  #undef PKW
  #undef PAF
  #undef VFR
  #undef PIN
  #undef MX3
  #undef GAPA
  #undef GAPB
  #undef EX
  #undef VRD
  #undef KRD
  #undef STEP
  #undef ENDW
  {auto rr=__builtin_amdgcn_permlane32_swap(__float_as_uint(l_reg),__float_as_uint(l_reg),false,false);l_reg=__uint_as_float(rr[0])+__uint_as_float(rr[1]);}
  if(hi==0)wsf[32+r32]=l_reg;asm volatile("s_waitcnt lgkmcnt(0)":::"memory");
  float rli[16];
  #pragma unroll
  for(int r=0;r<16;++r)rli[r]=__builtin_amdgcn_rcpf(wsf[32+crow(r,hi)]);
  bf16*Ow=O+(rowbase+q0+wid*QBLK)*DM+hv*D;
  { bf16*stg=(bf16*)(shm+LDS_OST)+wid*2048;
    #pragma unroll
    for(int r=0;r<16;++r){const int orow=crow(r,hi);
      #pragma unroll
      for(int d0=0;d0<2;++d0)stg[orow*64+d0*32+r32]=__float2bfloat16(o[d0][r]*rli[r]);}
    asm volatile("s_waitcnt lgkmcnt(0)":::"memory");
    #pragma unroll
    for(int i=0;i<4;++i){const int row=i*8+(lane>>3),ch=lane&7; const u32x4 v=*(const u32x4*)(stg+row*64+ch*8); if(q0+wid*QBLK+row<TREAL){ATTN_STORE16(Ow+(long)row*DM+ch*8,v);}} }
  asm volatile("s_waitcnt lgkmcnt(0)\n\ts_barrier":::"memory");
  #undef DMA_K
  #undef DMA_V
  #undef DMA_M
  #undef MMASK
  #undef CMASK
  #undef START
  #undef RESC
  #undef ROT
}
constexpr int ATTN_LDS_BYTES=LDS_BYTES;
#undef SBAR
#undef WAIT_BAR
}

#define GAS __attribute__((address_space(1)))
#define LAS __attribute__((address_space(3)))
typedef unsigned short bf16;
typedef unsigned v4u __attribute__((ext_vector_type(4)));
typedef float f32x4 __attribute__((ext_vector_type(4)));
typedef short bf16x8 __attribute__((ext_vector_type(8)));
typedef GAS unsigned gu32;
typedef GAS unsigned long long gu64;
#define RLX_AGENT __ATOMIC_RELAXED, __HIP_MEMORY_SCOPE_AGENT
#define LDS_WAIT() asm volatile("s_waitcnt lgkmcnt(0)" ::: "memory")
#define VM_WAIT() asm volatile("s_waitcnt vmcnt(0)" ::: "memory")
__device__ __forceinline__ unsigned long long rt() { return __builtin_amdgcn_s_memrealtime(); }
__device__ __forceinline__ unsigned f2bf(float f) { unsigned u = __builtin_bit_cast(unsigned, f); return (u + 0x7fffu + ((u >> 16) & 1u)) >> 16; }
__device__ __forceinline__ unsigned pk2(float lo, float hi) { return f2bf(lo) | (f2bf(hi) << 16); }

#define XB_TMO      128
#define XB_XCNT(j)  (256  + 64 * (j))
#define XB_XSUB(j)  (1280 + 64 * (j))
#define XB_XGEN(j)  (2304 + 64 * (j))
#define XB_TOP      3328
#define XB_TOPGEN   3392
#define XCD_BAR_WORDS 3456
#define XB_SPIN_CAP (1u << 22)

__device__ __forceinline__ unsigned xb_ld(unsigned* p)              { return __hip_atomic_load(p, __ATOMIC_RELAXED, __HIP_MEMORY_SCOPE_AGENT); }
__device__ __forceinline__ unsigned xb_add(unsigned* p, unsigned v) { return __hip_atomic_fetch_add(p, v, __ATOMIC_RELAXED, __HIP_MEMORY_SCOPE_AGENT); }
__device__ __forceinline__ unsigned xb_xcc_id() { return (unsigned)__builtin_amdgcn_s_getreg((3 << 11) | 20) & 0xFu; }
#define XB_SPIN(cond, bar) do { unsigned _sp = 0; while (cond) { __builtin_amdgcn_s_sleep(1); \
    if ((++_sp & 255u) == 0u) { if (xb_ld(&(bar)[XB_TMO])) break; if (_sp > XB_SPIN_CAP) { atomicAdd(&(bar)[XB_TMO], 1u); break; } } } } while (0)

struct XcdBarrier {
    unsigned* bar; unsigned x;
    volatile LAS unsigned* st;
};

__device__ __forceinline__ XcdBarrier xcd_barrier_post(unsigned* bar, volatile LAS unsigned* st) {
    XcdBarrier b; b.bar = bar; b.x = xb_xcc_id(); b.st = st;
    if (threadIdx.x == 0) (void)xb_add(&bar[XB_XCNT(b.x)], 1u);
    return b;
}
__device__ __forceinline__ void xcd_barrier_complete(unsigned* bar, unsigned x, unsigned& nloc, unsigned& nx) {
    const unsigned G = gridDim.x * gridDim.y * gridDim.z;
    unsigned sum, cnt, mine, sp = 0u;
    for (;;) {
        sum = 0u; cnt = 0u; mine = 0u;
#pragma unroll
        for (unsigned j = 0; j < 16; ++j) { const unsigned c = xb_ld(&bar[XB_XCNT(j)]); sum += c; cnt += (c > 0u) ? 1u : 0u; mine = (j == x) ? c : mine; }
        if (sum == G) break;
        __builtin_amdgcn_s_sleep(1);
        if ((++sp & 255u) == 0u) { if (xb_ld(&bar[XB_TMO])) break; if (sp > XB_SPIN_CAP) { atomicAdd(&bar[XB_TMO], 1u); break; } }
    }
    nloc = mine > 0u ? mine : 1u; nx = cnt > 0u ? cnt : 1u;
}

__device__ __forceinline__ void xcd_barrier(const XcdBarrier& b) {
    asm volatile("s_waitcnt vmcnt(0)" ::: "memory");
    __syncthreads();
    if (threadIdx.x == 0) {
        unsigned* bar = b.bar;
        __builtin_amdgcn_s_waitcnt(0);
        unsigned nloc = b.st[0], nx = b.st[1];
        if (nloc == 0u) { xcd_barrier_complete(bar, b.x, nloc, nx); b.st[0] = nloc; b.st[1] = nx; }
        const unsigned old = xb_add(&bar[XB_XSUB(b.x)], 1u);
        const unsigned gen = old / nloc;
        if (old + 1u == (gen + 1u) * nloc) {
            __builtin_amdgcn_fence(__ATOMIC_RELEASE, "agent");
            asm volatile("s_waitcnt vmcnt(0)" ::: "memory");
            const unsigned og = xb_add(&bar[XB_TOP], 1u);
            const unsigned tg = og / nx;
            if (og + 1u == (tg + 1u) * nx) xb_add(&bar[XB_TOPGEN], 1u);
            else XB_SPIN(xb_ld(&bar[XB_TOPGEN]) == tg, bar);
            __builtin_amdgcn_fence(__ATOMIC_ACQUIRE, "agent");
            xb_add(&bar[XB_XGEN(b.x)], 1u);
            asm volatile("s_waitcnt vmcnt(0)" ::: "memory");
        } else {
            XB_SPIN(xb_ld(&bar[XB_XGEN(b.x)]) == gen, bar);
            __builtin_amdgcn_fence(__ATOMIC_ACQUIRE, "agent");
            asm volatile("s_waitcnt vmcnt(0)" ::: "memory");
        }
    }
    __syncthreads();
}

typedef float f32x16 __attribute__((ext_vector_type(16)));
typedef unsigned u32x2 __attribute__((ext_vector_type(2)));
constexpr int NBATCH = 2, SEQL = 16384, DMODEL = 1024, NMETA = 16, TREAL = 16400, TALLOC = 16640, MALLOC = 2 * TALLOC;
constexpr int NWAVES = 8, MTILES = 32768;
constexpr int FFN_H = 2816, FA = 1536, FB = 1280;
constexpr int NIN = 3656, NIN_PAD = 3840, SIDE_W = 640, NSIDE = 584;
constexpr float RMS_EPS = 1e-6f;
constexpr float QSCALE = 0.125f * 1.4426950408889634f;
constexpr int MWORDS = 520;
constexpr int TOPK_NM = 240, TIE_CAP = 64;
constexpr float LAMBDA_INIT0 = 0.2f;

constexpr size_t MiB = 1u << 20;
constexpr size_t WS_CTL = 0, CTL_ZERO_BYTES = 1 * MiB;
constexpr size_t WS_WQKV = 2 * MiB, WS_WO1 = 8 * MiB, WS_WIN = 10 * MiB, WS_WO2 = 18 * MiB;
constexpr size_t WS_WUPA = 20 * MiB  , WS_WUPB = 32 * MiB  , WS_WDNA = 42 * MiB  , WS_WDNB = 48 * MiB  ;
constexpr size_t WS_COS = 54 * MiB, WS_SIN = 57 * MiB;
constexpr size_t WS_H = 60 * MiB;
constexpr size_t WS_XN = 190 * MiB;
constexpr size_t WS_Q = 255 * MiB, WS_K = 320 * MiB, WS_V = 385 * MiB;
constexpr size_t WS_QI = 450 * MiB, WS_KI = 483 * MiB, WS_WI = 488 * MiB, WS_END = 512 * MiB;
constexpr size_t QKV_STRIDE = (WS_K - WS_Q) / 2;
static_assert(WS_V - WS_K == WS_K - WS_Q, "Q|K|V equally spaced");
constexpr int CW_BAR = 4096;

constexpr int RING_BYTES = 131072, LDSCTL_OFF = RING_BYTES, MISC_OFF = LDSCTL_OFF + 320, ORD_OFF = LDSCTL_OFF + 1024, LDS_BYTES = 147456;

__constant__ float ROPE_INV[32] = {
    1.000000000e+00f, 7.498942614e-01f, 5.623413324e-01f, 4.216965139e-01f, 3.162277639e-01f, 2.371373773e-01f, 1.778279394e-01f, 1.333521307e-01f,
    1.000000015e-01f, 7.498941571e-02f, 5.623413250e-02f, 4.216965288e-02f, 3.162277490e-02f, 2.371373773e-02f, 1.778279431e-02f, 1.333521493e-02f,
    9.999999776e-03f, 7.498941850e-03f, 5.623413250e-03f, 4.216964822e-03f, 3.162277630e-03f, 2.371373586e-03f, 1.778279431e-03f, 1.333521446e-03f,
    1.000000047e-03f, 7.498942432e-04f, 5.623413017e-04f, 4.216965172e-04f, 3.162277571e-04f, 2.371373703e-04f, 1.778279402e-04f, 1.333521504e-04f};

__device__ __forceinline__ float wave_sum(float v) {
#pragma unroll
    for (int o = 1; o < 64; o <<= 1) v += __shfl_xor(v, o);
    return v;
}
__device__ __forceinline__ int crow32(int r, int hi) { return (r & 3) + 8 * (r >> 2) + 4 * hi; }
__device__ __forceinline__ unsigned long long pk4(f32x4 v) { return (unsigned long long)pk2(v.x, v.y) | ((unsigned long long)pk2(v.z, v.w) << 32); }
__device__ __forceinline__ int metarow(int r) { return (r >> 4) * TALLOC + (r & 15); }
__device__ __forceinline__ float bf2f(unsigned short b) { return __uint_as_float((unsigned)b << 16); }

template <class Q> struct EpiOf {
    static constexpr bool PERM = false, AFTER_DRAIN = false;
    Q q;
    __device__ __forceinline__ void operator()(const pg8::f32x4 (&acc)[2][2][4][2], const pg8::Unit& u, int wr, int wc, int fr, int fq) const {
        const int row0 = pg8::arow(u.pm) + wr * 64 + fr;
#pragma unroll
        for (int ai = 0; ai < 2; ++ai)
#pragma unroll
            for (int m = 0; m < 4; ++m)
#pragma unroll
                for (int bj = 0; bj < 2; ++bj) q.quad(row0 + ai * 128 + m * 16, u.pn, bj, wc, fq, acc[ai][bj][m][0], acc[ai][bj][m][1]);
    }
};
struct QuadRope {
    bf16* Q; float* side; const float *cosT, *sinT;
    __device__ __forceinline__ void quad(int row, int pn, int bj, int wc, int fq, f32x4 v0, f32x4 v1) const {
        if (pn < 12) {
            const int t = pn >> 2, g = bj * 4 + wc, hh = (pn & 3) * 4 + (g >> 1), db = 16 * (g & 1) + 4 * fq;
            f32x4 y0 = v0, y1 = v1;
            if (t < 2) {
                const int pos = row >= TALLOC ? row - TALLOC : row;
                const f32x4 c = *(const f32x4*)(cosT + pos * 32 + db), s = *(const f32x4*)(sinT + pos * 32 + db);
                y0 = v0 * c - v1 * s; y1 = v1 * c + v0 * s;
                if (t == 0) { y0 = y0 * QSCALE; y1 = y1 * QSCALE; }
            }
            bf16* dst = Q + (size_t)t * QKV_STRIDE + (size_t)row * 1024 + hh * 64 + db;
            *(unsigned long long*)dst = pk4(y0); *(unsigned long long*)(dst + 32) = pk4(y1);
        } else {
            const int col = 256 * pn + 128 * bj + 32 * wc + 4 * fq - 3072;
            if (col < NSIDE) *(f32x4*)(side + (size_t)row * SIDE_W + col) = v0;
            if (col + 16 < NSIDE) *(f32x4*)(side + (size_t)row * SIDE_W + col + 16) = v1;
        }
    }
};
struct QuadResid {
    float* H;
    __device__ __forceinline__ void quad(int row, int pn, int bj, int wc, int fq, f32x4 v0, f32x4 v1) const {
        float* p = H + (size_t)row * 1024 + 256 * pn + 128 * bj + 32 * wc + 4 * fq;
        const f32x4 a = *(const f32x4*)p, b = *(const f32x4*)(p + 16);
        *(f32x4*)p = a + v0; *(f32x4*)(p + 16) = b + v1;
    }
};
struct QuadPlain {
    bf16* U; int ldu;
    __device__ __forceinline__ void quad(int row, int pn, int bj, int wc, int fq, f32x4 v0, f32x4 v1) const {
        bf16* p = U + (size_t)row * ldu + 256 * pn + 128 * bj + 32 * wc + 4 * fq;
        *(unsigned long long*)p = pk4(v0); *(unsigned long long*)(p + 16) = pk4(v1);
    }
};

template <class Q> __device__ __forceinline__ void run_gemm(LAS unsigned char* lds, const bf16* A, const bf16* Bt, int N, int K, const Q& q, int G) {
    pg8::Gemm g{A, Bt, MTILES, N, K}; pg8::StaticOrder S; S.init(MTILES, N, G, (int)blockIdx.x);
    EpiOf<Q> E{q};
    pg8::gemm_phase<EpiOf<Q>, pg8::StaticOrder, true, true>(lds, g, S, E);
}
template <class Q> __device__ __forceinline__ void meta_gemm(LAS unsigned char* lds, const bf16* A, const bf16* Bt, int N, int K, const Q& q, int vcu, int G) {
    int tid_ = threadIdx.x; asm volatile("" : "+v"(tid_));
    const int tid = tid_, lane = tid & 63, wid = __builtin_amdgcn_readfirstlane(tid >> 6), r32 = lane & 31, hi = lane >> 5;
    LAS float* tile = (LAS float*)lds;
    for (int pn = vcu; pn < N / 256; pn += G) {
        const bf16* ap = A + (size_t)metarow(r32) * K + 8 * hi;
        const bf16* bp = Bt + (size_t)(256 * pn + 32 * wid + r32) * K + 8 * hi;
        f32x16 acc = f32x16{};
#pragma unroll 8
        for (int kk = 0; kk < K / 16; ++kk) {
            const bf16x8 a = *(const bf16x8*)(ap + 16 * kk), b = *(const bf16x8*)(bp + 16 * kk);
            acc = __builtin_amdgcn_mfma_f32_32x32x16_bf16(a, b, acc, 0, 0, 0);
        }
#pragma unroll
        for (int r = 0; r < 16; ++r) tile[crow32(r, hi) * 260 + 32 * wid + r32] = acc[r];
        __syncthreads();
#pragma unroll
        for (int i = 0; i < 2; ++i) {
            const int v = tid * 2 + i, r = v >> 5, g = (v >> 2) & 7, fq = v & 3;
            const f32x4 x0 = *(const LAS f32x4*)(tile + r * 260 + 32 * g + 4 * fq), x1 = *(const LAS f32x4*)(tile + r * 260 + 32 * g + 16 + 4 * fq);
            q.quad(metarow(r), pn, g >> 2, g & 3, fq, x0, x1);
        }
        __syncthreads();
    }
}

struct Mat { const float* W; int ldw, koff, Kp, Np, map; bf16* WT; };
__device__ __forceinline__ int rope_sigma(int n) { const int pn = n >> 8, p = n & 255, g = p >> 5, nn = (p >> 4) & 1, r = p & 15; return 256 * pn + 64 * (g >> 1) + 32 * nn + 16 * (g & 1) + r; }
__device__ __forceinline__ int src_col(int map, int n) {
    if (map == 0) return n;
    if (map == 1) return rope_sigma(n);
    if (map == 2) return n < 3072 ? rope_sigma(n) : (n < NIN ? n : -1);
    if (map == 3) return n < FA ? n : FFN_H + (n - FA);
    return n < FB ? FA + n : FFN_H + FA + (n - FB);
}
__device__ __forceinline__ void wt_item(const Mat& m, int item, LAS float* scr, int lane) {
    const int nblk = m.Np / 32, kb = item / nblk, nb = item % nblk, k0 = 64 * kb, n0 = 32 * nb;
    const int src = src_col(m.map, n0 + (lane & 31));
#pragma unroll 8
    for (int i = 0; i < 32; ++i) { const int kk = 2 * i + (lane >> 5); scr[kk * 33 + (lane & 31)] = src >= 0 ? m.W[(size_t)(m.koff + k0 + kk) * m.ldw + src] : 0.f; }
    LDS_WAIT(); asm volatile("" ::: "memory");
    const int c = lane & 7;
#pragma unroll
    for (int j = 0; j < 4; ++j) { const int n = (lane >> 3) + 8 * j; const LAS float* s = scr + (8 * c) * 33 + n;
        v4u o; o.x = pk2(s[0 * 33], s[1 * 33]); o.y = pk2(s[2 * 33], s[3 * 33]); o.z = pk2(s[4 * 33], s[5 * 33]); o.w = pk2(s[6 * 33], s[7 * 33]);
        *(v4u*)(m.WT + (size_t)(n0 + n) * m.Kp + k0 + 8 * c) = o; }
    LDS_WAIT(); asm volatile("" ::: "memory");
}
__device__ __forceinline__ void rms_row_bf16(const float* xrow, const float* g, bf16* orow, float* copy, int lane) {
    const f32x4* xr = (const f32x4*)xrow + lane; f32x4 v[4]; float s = 0.f;
#pragma unroll
    for (int j = 0; j < 4; ++j) { v[j] = xr[64 * j]; s += (v[j].x * v[j].x + v[j].y * v[j].y) + (v[j].z * v[j].z + v[j].w * v[j].w); }
    const float r = 1.0f / sqrtf(wave_sum(s) * (1.f / 1024.f) + RMS_EPS);
    unsigned long long* o8 = (unsigned long long*)orow + lane; const f32x4* gr = (const f32x4*)g + lane;
#pragma unroll
    for (int j = 0; j < 4; ++j) { const f32x4 gg = gr[64 * j]; o8[64 * j] = pk4(v[j] * r * gg); if (copy) ((f32x4*)copy + lane)[64 * j] = v[j]; }
}

struct Args { const float* in[20]; float* out; unsigned char* ws; int ph_lo, ph_hi; };
enum { IN_X = 0, IN_META, IN_DA_NORM, IN_DA_WQKV, IN_LQ1, IN_LK1, IN_LQ2, IN_LK2, IN_SUBLN, IN_DA_WO, IN_DSA_NORM, IN_DSA_WIN, IN_IDX_KNORM, IN_DSA_WO, IN_FFN_NORM, IN_FFN_WUP, IN_CONV_W, IN_CONV_B, IN_FFN_WDN, IN_FINAL_NORM };
constexpr int N_PHASES = 25;

__global__ void __launch_bounds__(NWAVES * 64, 2) fwd(Args args) {
    extern __shared__ __attribute__((aligned(16))) unsigned char lds_raw[];
    LAS unsigned char* lds = (LAS unsigned char*)lds_raw;
    volatile LAS unsigned* MISC = (volatile LAS unsigned*)(lds + MISC_OFF);
    const int G = gridDim.x, bx = blockIdx.x, vcu = (G % 8 == 0) ? (bx % 8) * (G / 8) + bx / 8 : bx;
    const int NGW = G * NWAVES, NGT = NGW * 64;
#define PTRS() unsigned char* ws = args.ws; float* outp = args.out; asm volatile("" : "+s"(ws), "+s"(outp)); \
    int tid_ = threadIdx.x; asm volatile("" : "+v"(tid_)); const int tid = tid_, lane = tid & 63, wave = __builtin_amdgcn_readfirstlane(tid >> 6); \
    const int gw = vcu * NWAVES + wave, gtid = gw * 64 + lane; (void)gw; (void)gtid; (void)lane; \
    bf16* const WQKV_T = (bf16*)(ws + WS_WQKV); bf16* const WO1_T = (bf16*)(ws + WS_WO1); bf16* const WIN_T = (bf16*)(ws + WS_WIN); bf16* const WO2_T = (bf16*)(ws + WS_WO2); \
    float* const COS = (float*)(ws + WS_COS); float* const SIN = (float*)(ws + WS_SIN); float* const H = (float*)(ws + WS_H); \
    bf16* const XN = (bf16*)(ws + WS_XN); bf16* const QB = (bf16*)(ws + WS_Q); bf16* const KB = (bf16*)(ws + WS_K); bf16* const VB = (bf16*)(ws + WS_V); bf16* const UB = (bf16*)(ws + WS_Q); \
    bf16* const QI = (bf16*)(ws + WS_QI); bf16* const KI = (bf16*)(ws + WS_KI); float* const WI = (float*)(ws + WS_WI); \
    bf16* const O0 = XN; bf16* const O1 = (bf16*)outp; bf16* const ACT = (bf16*)outp; float* const SIDE = outp; unsigned* const MASK = (unsigned*)outp; \
    (void)WQKV_T; (void)WO1_T; (void)WIN_T; (void)WO2_T; (void)COS; (void)SIN; (void)H; (void)XN; (void)QB; (void)KB; (void)VB; (void)UB; (void)QI; (void)KI; (void)WI; (void)O0; (void)O1; (void)ACT; (void)SIDE; (void)MASK
    gu32* ctl = (gu32*)(args.ws + WS_CTL);
    for (int u = threadIdx.x; u < (LDS_BYTES - LDSCTL_OFF) / 4; u += NWAVES * 64) ((LAS unsigned*)(lds + LDSCTL_OFF))[u] = 0u;
    __syncthreads();
    const int lo = args.ph_lo, hi_ph = args.ph_hi;
    const bool use_bar = (hi_ph - lo) > 1;
    XcdBarrier bar; bar.bar = (unsigned*)(ctl + CW_BAR); bar.x = 0; bar.st = nullptr;
    if (use_bar) bar = xcd_barrier_post((unsigned*)(ctl + CW_BAR), MISC + 8);
#ifndef EN_MASK
#define EN_MASK 0x1fff
#endif
#define IN(k) (lo <= (k) && (k) < hi_ph)
#define INA(a) ((((EN_MASK) >> (a)) & 1) && IN(P + (a)))
#define SEAM(k) do { if (IN(k) && IN((k) + 1)) xcd_barrier(bar); } while (0)

    if (((EN_MASK >> 12) & 1) && IN(0)) { PTRS();
        LAS float* scr = (LAS float*)(lds + wave * 16384);
        constexpr int I0 = 16 * 96, I1 = 16 * 32, I2 = 16 * 120, I3 = 16 * 32, IUA = 16 * 96, IUB = 16 * 80, IDA = 24 * 32, IDB = 20 * 32;
        constexpr int NITEMS = I0 + I1 + I2 + I3 + 2 * (IUA + IUB + IDA + IDB);
        for (int it = gw; it < NITEMS; it += NGW) {
            int r = it; Mat m;
            if (r < I0) m = Mat{args.in[IN_DA_WQKV], 3072, 0, 1024, 3072, 1, WQKV_T};
            else if ((r -= I0) < I1) m = Mat{args.in[IN_DA_WO], 1024, 0, 1024, 1024, 0, WO1_T};
            else if ((r -= I1) < I2) m = Mat{args.in[IN_DSA_WIN], NIN, 0, 1024, NIN_PAD, 2, WIN_T};
            else if ((r -= I2) < I3) m = Mat{args.in[IN_DSA_WO], 1024, 0, 1024, 1024, 0, WO2_T};
            else { r -= I3; const int per = IUA + IUB + IDA + IDB, l = r / per; r -= l * per;
                const float* wup = args.in[IN_FFN_WUP] + (size_t)l * 1024 * 2 * FFN_H; const float* wdn = args.in[IN_FFN_WDN] + (size_t)l * FFN_H * 1024;
                if (r < IUA) m = Mat{wup, 2 * FFN_H, 0, 1024, 2 * FA, 3, (bf16*)(ws + WS_WUPA + l * 6 * MiB)};
                else if ((r -= IUA) < IUB) m = Mat{wup, 2 * FFN_H, 0, 1024, 2 * FB, 4, (bf16*)(ws + WS_WUPB + l * 5 * MiB)};
                else if ((r -= IUB) < IDA) m = Mat{wdn, 1024, 0, FA, 1024, 0, (bf16*)(ws + WS_WDNA + l * 3 * MiB)};
                else { r -= IDA; m = Mat{wdn, 1024, FA, FB, 1024, 0, (bf16*)(ws + WS_WDNB + l * (5 * MiB / 2))}; } }
            wt_item(m, r, scr, lane);
        }
        for (int i = gtid; i < TALLOC * 32; i += NGT) { const float ang = (float)(i >> 5) * ROPE_INV[i & 31]; COS[i] = (float)cos((double)ang); SIN[i] = (float)sin((double)ang); }
        for (int r = gw; r < NBATCH * TREAL; r += NGW) { const int b = r / TREAL, pos = r - b * TREAL, row = b * TALLOC + pos;
            const float* src = pos < NMETA ? args.in[IN_META] + (size_t)pos * 1024 : args.in[IN_X] + ((size_t)b * SEQL + pos - NMETA) * 1024;
            rms_row_bf16(src, args.in[IN_DA_NORM], XN + (size_t)row * 1024, H + (size_t)row * 1024, lane); }
        for (int r = gw; r < 2 * NBATCH * (TALLOC - TREAL); r += NGW) { const int which = r / (NBATCH * (TALLOC - TREAL)), rr = r % (NBATCH * (TALLOC - TREAL)), b = rr / (TALLOC - TREAL), pos = TREAL + rr % (TALLOC - TREAL);
            v4u* p = (v4u*)(KB + (size_t)which * QKV_STRIDE + (size_t)(b * TALLOC + pos) * 1024); unsigned z = 0u; asm volatile("" : "+v"(z)); p[lane] = v4u{z, z, z, z}; p[lane + 64] = v4u{z, z, z, z}; }
    }
    SEAM(0);

    for (int layer = 0; layer < 2; ++layer) {
        const int P = 1 + 12 * layer;
        if (INA(0)) { PTRS();
            const QuadRope q{QB, SIDE, COS, SIN};
            const bf16* Wt = layer == 0 ? WQKV_T : WIN_T; const int N = layer == 0 ? 3072 : NIN_PAD;
            run_gemm(lds, XN, Wt, N, 1024, q, G);
            meta_gemm(lds, XN, Wt, N, 1024, q, vcu, G);
        }
        SEAM(P + 0);
        if (INA(1)) { PTRS();
            if (layer == 0) {
                LAS int* ord = (LAS int*)(lds + ORD_OFF);
                constexpr int NSTREAM = 64;
                if (G % NSTREAM == 0) {
                    const int cps = G / NSTREAM, s = vcu / cps, j = vcu % cps;
                    if (tid == 0) { int z = 0; asm volatile("" : "+v"(z)); for (int i = 0; i < cps; ++i) ord[80 + i] = z; int n = 0;
                        for (int qb = 64; qb >= 0; --qb) { int best = 0; for (int i = 1; i < cps; ++i) if (ord[80 + i] < ord[80 + best]) best = i; ord[80 + best] += 4 * qb + 4; if (best == j) ord[1 + n++] = qb; }
                        ord[0] = n; }
                    __syncthreads();
                    const int n = __builtin_amdgcn_readfirstlane(ord[0]);
                    const int b = s >> 5, h = (s >> 2) & 7, c = (s >> 1) & 1, e = s & 1;
                    for (int i = 0; i < n; ++i) { const int qb = __builtin_amdgcn_readfirstlane(ord[1 + i]);
                        attn_body::attn_unit<8, false>(b, 2 * h + c, 2 * h + e, qb, (const attn_body::bf16*)QB, (const attn_body::bf16*)KB, (const attn_body::bf16*)VB, (attn_body::bf16*)(c ? O1 : O0), nullptr, (char*)lds_raw); }
                } else {
                    for (int uid = vcu; uid < NSTREAM * 65; uid += G) { const int s = uid / 65, qb = 64 - uid % 65, b = s >> 5, h = (s >> 2) & 7, c = (s >> 1) & 1, e = s & 1;
                        attn_body::attn_unit<8, false>(b, 2 * h + c, 2 * h + e, qb, (const attn_body::bf16*)QB, (const attn_body::bf16*)KB, (const attn_body::bf16*)VB, (attn_body::bf16*)(c ? O1 : O0), nullptr, (char*)lds_raw); }
                }
            } else {
                for (int r = gw; r < NBATCH * TREAL; r += NGW) { const int b = r / TREAL, pos = r - b * TREAL, row = b * TALLOC + pos;
                    const float* src = SIDE + (size_t)row * SIDE_W; const int h = lane >> 3, d4 = (lane & 7) * 4;
                    const f32x4 c = *(const f32x4*)(COS + pos * 32 + d4), s = *(const f32x4*)(SIN + pos * 32 + d4);
                    { const f32x4 x1 = *(const f32x4*)(src + h * 64 + d4), x2 = *(const f32x4*)(src + h * 64 + 32 + d4);
                      bf16* dst = QI + (size_t)row * 512 + h * 64 + d4; *(unsigned long long*)dst = pk4(x1 * c - x2 * s); *(unsigned long long*)(dst + 32) = pk4(x2 * c + x1 * s); }
                    { f32x4 k1 = *(const f32x4*)(src + 512 + d4), k2 = *(const f32x4*)(src + 544 + d4);
                      float ss = (k1.x * k1.x + k1.y * k1.y) + (k1.z * k1.z + k1.w * k1.w) + (k2.x * k2.x + k2.y * k2.y) + (k2.z * k2.z + k2.w * k2.w);
                      ss += __shfl_xor(ss, 1); ss += __shfl_xor(ss, 2); ss += __shfl_xor(ss, 4);
                      const float rr = 1.0f / sqrtf(ss * (1.f / 64.f) + RMS_EPS);
                      const f32x4 g1 = *(const f32x4*)(args.in[IN_IDX_KNORM] + d4), g2 = *(const f32x4*)(args.in[IN_IDX_KNORM] + 32 + d4);
                      k1 = k1 * rr * g1; k2 = k2 * rr * g2;
                      if (lane < 8) { bf16* dst = KI + (size_t)row * 64 + d4; *(unsigned long long*)dst = pk4(k1 * c - k2 * s); *(unsigned long long*)(dst + 32) = pk4(k2 * c + k1 * s); } }
                    if (lane < 8) WI[(size_t)row * 8 + lane] = src[576 + lane] * (0.35355339059327373f * 0.125f);
                }
            }
        }
        SEAM(P + 1);
        if (INA(2)) { PTRS();
            if (layer == 0) {
                float lam;
                { const float a1 = args.in[IN_LQ1][lane] * args.in[IN_LK1][lane], a2 = args.in[IN_LQ2][lane] * args.in[IN_LK2][lane];
                  lam = expf(wave_sum(a1)) - expf(wave_sum(a2)) + LAMBDA_INIT0; }
                for (int r = gw; r < NBATCH * TREAL; r += NGW) { const int b = r / TREAL, pos = r - b * TREAL, row = b * TALLOC + pos;
                    const v4u* p0 = (const v4u*)(O0 + (size_t)row * 1024 + lane * 16); const v4u* p1 = (const v4u*)(O1 + (size_t)row * 1024 + lane * 16);
                    const v4u a0 = p0[0], a1 = p0[1], b0 = p1[0], b1 = p1[1];
                    const unsigned aw[8] = {a0.x, a0.y, a0.z, a0.w, a1.x, a1.y, a1.z, a1.w}, bw[8] = {b0.x, b0.y, b0.z, b0.w, b1.x, b1.y, b1.z, b1.w};
                    float o[16]; float ss = 0.f;
#pragma unroll
                    for (int i = 0; i < 8; ++i) { o[2 * i] = __uint_as_float(aw[i] << 16) - lam * __uint_as_float(bw[i] << 16); o[2 * i + 1] = __uint_as_float(aw[i] & 0xffff0000u) - lam * __uint_as_float(bw[i] & 0xffff0000u);
                        ss += o[2 * i] * o[2 * i] + o[2 * i + 1] * o[2 * i + 1]; }
                    ss += __shfl_xor(ss, 1); ss += __shfl_xor(ss, 2); ss += __shfl_xor(ss, 4);
                    const float rr = (1.0f - LAMBDA_INIT0) / sqrtf(ss * (1.f / 128.f) + RMS_EPS);
                    const float* sg = args.in[IN_SUBLN] + (lane & 7) * 16; unsigned w[8];
#pragma unroll
                    for (int i = 0; i < 8; ++i) w[i] = pk2(o[2 * i] * rr * sg[2 * i], o[2 * i + 1] * rr * sg[2 * i + 1]);
                    v4u* dst = (v4u*)(QB + (size_t)row * 1024 + lane * 16); dst[0] = v4u{w[0], w[1], w[2], w[3]}; dst[1] = v4u{w[4], w[5], w[6], w[7]};
                }
            } else {
                LAS unsigned* hist = (LAS unsigned*)lds;
                LAS unsigned* st_klo = (LAS unsigned*)(lds + 65536), *st_khi = st_klo + 32, *st_cab = st_klo + 64, *st_done = st_klo + 96, *tie_cnt = st_klo + 128;
                LAS unsigned* tie_key = (LAS unsigned*)(lds + 65536 + 1024), *tie_pos = tie_key + 32 * TIE_CAP;
                LAS unsigned char* qlds = lds + 90112;
                const int qi = lane & 31, hi = lane >> 5;
                constexpr int NUNIT = 2 * 513;
                for (int round = 0;; ++round) {
                    const int rank = round * G + ((round & 1) ? (G - 1 - vcu) : vcu); if (rank >= NUNIT) break;
                    const int b = rank & 1, u = 512 - (rank >> 1), q_lo = 32 * u, rowbase = b * TALLOC, pos_q = q_lo + qi, NB = u + 1, NSB = (NB + 3) >> 2;
                    const bool sel = u >= 8, active = pos_q < TREAL;
                    const int prow = active ? pos_q : TREAL - 1;
                    { const bf16* qp = QI + (size_t)(rowbase + prow) * 512 + hi * 8 + wave * 64;
#pragma unroll
                      for (int kk = 0; kk < 4; ++kk) *(LAS bf16x8*)(qlds + (wave * 4 + kk) * 1024 + lane * 16) = *(const bf16x8*)(qp + kk * 16); }
                    float wq[8];
                    { const f32x4 w0 = *(const f32x4*)(WI + (size_t)(rowbase + prow) * 8), w1 = *(const f32x4*)(WI + (size_t)(rowbase + prow) * 8 + 4);
                      wq[0] = w0.x; wq[1] = w0.y; wq[2] = w0.z; wq[3] = w0.w; wq[4] = w1.x; wq[5] = w1.y; wq[6] = w1.z; wq[7] = w1.w; }
                    if (tid < 32) { st_klo[tid] = 0u; st_khi[tid] = 0xffffffffu; st_cab[tid] = 0u; st_done[tid] = (!sel || q_lo + tid >= TREAL) ? 1u : 0u; tie_cnt[tid] = 0u; }
                    __syncthreads();
                    unsigned klo_q = 0u, khi_q = 0xffffffffu; bool done_q = true; int shift = 22;
#define TK_SWEEP(MODE) do { \
    for (int sb = wave; 4 * sb < NB; sb += 8) { unsigned mw[4] = {0u, 0u, 0u, 0u}; \
        _Pragma("unroll") for (int j = 0; j < 4; ++j) { const int kb = 4 * sb + j; if (kb < NB) { \
            const bf16* kp = KI + (size_t)(rowbase + 32 * kb + qi) * 64 + hi * 8; bf16x8 kf[4]; \
            _Pragma("unroll") for (int kk = 0; kk < 4; ++kk) kf[kk] = *(const bf16x8*)(kp + kk * 16); \
            float sc[16]; _Pragma("unroll") for (int r = 0; r < 16; ++r) sc[r] = 0.f; \
            _Pragma("unroll") for (int h = 0; h < 8; ++h) { f32x16 acc = f32x16{}; \
                _Pragma("unroll") for (int kk = 0; kk < 4; ++kk) acc = __builtin_amdgcn_mfma_f32_32x32x16_bf16(kf[kk], *(const LAS bf16x8*)(qlds + (h * 4 + kk) * 1024 + lane * 16), acc, 0, 0, 0); \
                _Pragma("unroll") for (int r = 0; r < 16; ++r) sc[r] = __builtin_fmaf(wq[h], __builtin_fmaxf(acc[r], 0.f), sc[r]); } \
            const bool edge = (kb == 0) || (kb >= u); unsigned bits = 0u; \
            _Pragma("unroll") for (int r = 0; r < 16; ++r) { const int kpos = 32 * kb + crow32(r, hi); \
                const bool valid = !edge || (kpos >= NMETA && kpos <= pos_q); \
                const unsigned fb = __float_as_uint(sc[r] + 0.0f), key = fb ^ ((unsigned)((int)fb >> 31) | 0x80000000u); \
                if (MODE == 0) { if (valid && !done_q && key >= klo_q && key <= khi_q) { const unsigned bin = (key - klo_q) >> shift; \
                        __hip_atomic_fetch_add(hist + qi * 512 + (bin >> 1), 1u << ((bin & 1u) * 16u), __ATOMIC_RELAXED, __HIP_MEMORY_SCOPE_WORKGROUP); } } \
                else { bool take = false; \
                    if (active) { if (edge && kpos < NMETA) take = kpos <= pos_q; \
                        else if (valid) { if (!sel || key > khi_q) take = true; \
                            else if (key >= klo_q) { const unsigned ix = __hip_atomic_fetch_add(tie_cnt + qi, 1u, __ATOMIC_RELAXED, __HIP_MEMORY_SCOPE_WORKGROUP); \
                                if (ix < (unsigned)TIE_CAP) { tie_key[qi * TIE_CAP + ix] = key; tie_pos[qi * TIE_CAP + ix] = (unsigned)kpos; } } } } \
                    if (take) bits |= 1u << crow32(r, hi); } } \
            if (MODE == 1) { bits |= (unsigned)__shfl_xor((int)bits, 32); mw[j] = bits; } } } \
        if (MODE == 1 && hi == 0 && active) *(v4u*)(MASK + (size_t)(rowbase + pos_q) * MWORDS + 4 * sb) = v4u{mw[0], mw[1], mw[2], mw[3]}; } } while (0)
                    if (sel) {
                        for (int pass = 0; pass < 4; ++pass) {
                            shift = pass == 0 ? 22 : (pass == 1 ? 12 : (pass == 2 ? 2 : 0));
                            for (int i = tid; i < 32 * 512; i += NWAVES * 64) hist[i] = 0u;
                            klo_q = st_klo[qi]; khi_q = st_khi[qi]; done_q = st_done[qi] != 0u;
                            __syncthreads();
                            TK_SWEEP(0);
                            __syncthreads();
                            for (int qq = 4 * wave; qq < 4 * wave + 4; ++qq) {
                                if (st_done[qq] != 0u) continue;
                                const v4u h0 = *(const LAS v4u*)(hist + qq * 512 + 8 * lane), h1 = *(const LAS v4u*)(hist + qq * 512 + 8 * lane + 4);
                                const unsigned hw[8] = {h0.x, h0.y, h0.z, h0.w, h1.x, h1.y, h1.z, h1.w}; unsigned c[16]; unsigned s = 0u;
#pragma unroll
                                for (int i = 0; i < 8; ++i) { c[2 * i] = hw[i] & 0xffffu; c[2 * i + 1] = hw[i] >> 16; s += c[2 * i] + c[2 * i + 1]; }
                                unsigned suf = s;
#pragma unroll
                                for (int off = 1; off < 64; off <<= 1) { const unsigned t = (unsigned)__shfl_down((int)suf, off); if (lane + off < 64) suf += t; }
                                const unsigned need = (unsigned)TOPK_NM - st_cab[qq];
                                const unsigned long long bal = __ballot(suf >= need);
                                const int Ls = 63 - __builtin_clzll(bal | 1ull);
                                if (lane == Ls) { unsigned cum = suf - s, above = 0u, cnt = 0u; int jb = 0; bool found = false;
#pragma unroll
                                    for (int i = 15; i >= 0; --i) { if (!found) { if (cum + c[i] >= need) { found = true; jb = i; above = cum; cnt = c[i]; } else cum += c[i]; } }
                                    const unsigned klo_n = st_klo[qq] + ((unsigned)(16 * lane + jb) << shift);
                                    st_cab[qq] += above; st_klo[qq] = klo_n; st_khi[qq] = klo_n + ((1u << shift) - 1u);
                                    st_done[qq] = (cnt <= (unsigned)TIE_CAP || shift == 0) ? 1u : 0u; }
                            }
                            __syncthreads();
                            if (__all(st_done[qi] != 0u)) break;
                        }
                    }
                    klo_q = st_klo[qi]; khi_q = st_khi[qi];
                    TK_SWEEP(1);
                    { const int nz = 130 - NSB; for (int i = tid; i < 32 * nz; i += NWAVES * 64) { const int q = i / nz, sbz = NSB + i % nz; unsigned z = 0u; asm volatile("" : "+v"(z)); if (q_lo + q < TREAL) *(v4u*)(MASK + (size_t)(rowbase + q_lo + q) * MWORDS + 4 * sbz) = v4u{z, z, z, z}; } }
                    asm volatile("s_waitcnt vmcnt(0)" ::: "memory");
                    __syncthreads();
                    if (sel && tid < 32 && q_lo + tid < TREAL) { const int q = tid; const unsigned ntake = (unsigned)TOPK_NM - st_cab[q]; unsigned cnt = tie_cnt[q]; if (cnt > (unsigned)TIE_CAP) cnt = TIE_CAP;
                        for (unsigned i = 0; i < cnt; ++i) { const unsigned ki = tie_key[q * TIE_CAP + i], pi = tie_pos[q * TIE_CAP + i]; unsigned rk = 0u;
                            for (unsigned j2 = 0; j2 < cnt; ++j2) { const unsigned kj = tie_key[q * TIE_CAP + j2], pj = tie_pos[q * TIE_CAP + j2]; rk += (kj > ki || (kj == ki && pj < pi)) ? 1u : 0u; }
                            if (rk < ntake) atomicOr(MASK + (size_t)(rowbase + q_lo + q) * MWORDS + (pi >> 5), 1u << (pi & 31u)); } }
                    __syncthreads();
                }
#undef TK_SWEEP
            }
        }
        SEAM(P + 2);
        if (layer == 1) {
            if (INA(3)) { PTRS();
                LAS int* ord = (LAS int*)(lds + ORD_OFF);
                constexpr int NSTREAM = 32;
                if (G % NSTREAM == 0) {
                    const int cps = G / NSTREAM, s = vcu / cps, j = vcu % cps;
                    if (tid == 0) { int z = 0; asm volatile("" : "+v"(z)); for (int i = 0; i < cps; ++i) ord[80 + i] = z; int n = 0;
                        for (int qb = 64; qb >= 0; --qb) { int best = 0; for (int i = 1; i < cps; ++i) if (ord[80 + i] < ord[80 + best]) best = i; ord[80 + best] += 4 * qb + 4; if (best == j) ord[1 + n++] = qb; }
                        ord[0] = n; }
                    __syncthreads();
                    const int n = __builtin_amdgcn_readfirstlane(ord[0]);
                    for (int i = 0; i < n; ++i) { const int qb = __builtin_amdgcn_readfirstlane(ord[1 + i]);
                        attn_body::attn_unit<8, true>(s >> 4, s & 15, s & 15, qb, (const attn_body::bf16*)QB, (const attn_body::bf16*)KB, (const attn_body::bf16*)VB, (attn_body::bf16*)QB, MASK, (char*)lds_raw); }
                } else {
                    for (int uid = vcu; uid < NSTREAM * 65; uid += G) { const int s = uid / 65, qb = 64 - uid % 65;
                        attn_body::attn_unit<8, true>(s >> 4, s & 15, s & 15, qb, (const attn_body::bf16*)QB, (const attn_body::bf16*)KB, (const attn_body::bf16*)VB, (attn_body::bf16*)QB, MASK, (char*)lds_raw); }
                }
            }
            SEAM(P + 3);
        } else if (IN(P + 3) && IN(P + 4)) {   }
        if (INA(4)) { PTRS();
            const QuadResid q{H};
            const bf16* Wt = layer == 0 ? WO1_T : WO2_T;
            run_gemm(lds, QB, Wt, 1024, 1024, q, G);
            meta_gemm(lds, QB, Wt, 1024, 1024, q, vcu, G);
        }
        SEAM(P + 4);
        if (INA(5)) { PTRS();
            for (int r = gw; r < NBATCH * TREAL; r += NGW) { const int b = r / TREAL, pos = r - b * TREAL, row = b * TALLOC + pos;
                rms_row_bf16(H + (size_t)row * 1024, args.in[IN_FFN_NORM] + layer * 1024, XN + (size_t)row * 1024, nullptr, lane); }
        }
        SEAM(P + 5);
        if (INA(6)) { PTRS(); const bf16* WUA = (const bf16*)(ws + WS_WUPA + layer * 6 * MiB); const QuadPlain q{UB, 2 * FA}; run_gemm(lds, XN, WUA, 2 * FA, 1024, q, G); meta_gemm(lds, XN, WUA, 2 * FA, 1024, q, vcu, G); }
        SEAM(P + 6);
#define CONV_PHASE(NH, HOFF) do { \
    const float* cw = args.in[IN_CONV_W] + (size_t)layer * 3 * 2 * FFN_H; const float* cb = args.in[IN_CONV_B] + (size_t)layer * 2 * FFN_H; \
    constexpr int NC = (NH) / 8; \
    for (int it = gtid; it < NBATCH * TREAL * NC; it += NGT) { const int r = it / NC, c8 = (it - r * NC) * 8, b = r / TREAL, pos = r - b * TREAL, row = b * TALLOC + pos; \
        float ag[8], av[8]; \
        { const f32x4 b0 = *(const f32x4*)(cb + (HOFF) + c8), b1 = *(const f32x4*)(cb + (HOFF) + c8 + 4), d0 = *(const f32x4*)(cb + FFN_H + (HOFF) + c8), d1 = *(const f32x4*)(cb + FFN_H + (HOFF) + c8 + 4); \
          ag[0] = b0.x; ag[1] = b0.y; ag[2] = b0.z; ag[3] = b0.w; ag[4] = b1.x; ag[5] = b1.y; ag[6] = b1.z; ag[7] = b1.w; av[0] = d0.x; av[1] = d0.y; av[2] = d0.z; av[3] = d0.w; av[4] = d1.x; av[5] = d1.y; av[6] = d1.z; av[7] = d1.w; } \
        _Pragma("unroll") for (int i = 0; i < 3; ++i) { if (pos - 2 + i >= 0) { \
            const bf16* up = UB + (size_t)(row - 2 + i) * (2 * (NH)) + c8; const v4u ug = *(const v4u*)up, uv = *(const v4u*)(up + (NH)); \
            const float* wg = cw + (size_t)i * 2 * FFN_H + (HOFF) + c8; const float* wv = wg + FFN_H; \
            const f32x4 g0 = *(const f32x4*)wg, g1 = *(const f32x4*)(wg + 4), v0 = *(const f32x4*)wv, v1 = *(const f32x4*)(wv + 4); \
            const unsigned ugw[4] = {ug.x, ug.y, ug.z, ug.w}, uvw[4] = {uv.x, uv.y, uv.z, uv.w}; const float gw8[8] = {g0.x, g0.y, g0.z, g0.w, g1.x, g1.y, g1.z, g1.w}, vw8[8] = {v0.x, v0.y, v0.z, v0.w, v1.x, v1.y, v1.z, v1.w}; \
            _Pragma("unroll") for (int e = 0; e < 4; ++e) { ag[2 * e] += gw8[2 * e] * __uint_as_float(ugw[e] << 16); ag[2 * e + 1] += gw8[2 * e + 1] * __uint_as_float(ugw[e] & 0xffff0000u); \
                av[2 * e] += vw8[2 * e] * __uint_as_float(uvw[e] << 16); av[2 * e + 1] += vw8[2 * e + 1] * __uint_as_float(uvw[e] & 0xffff0000u); } } } \
        unsigned w[4]; \
        _Pragma("unroll") for (int e = 0; e < 4; ++e) { const float x0 = ag[2 * e], x1 = ag[2 * e + 1]; w[e] = pk2(x0 / (1.f + expf(-x0)) * av[2 * e], x1 / (1.f + expf(-x1)) * av[2 * e + 1]); } \
        *(v4u*)(ACT + (size_t)row * (NH) + c8) = v4u{w[0], w[1], w[2], w[3]}; } } while (0)
        if (INA(7)) { PTRS(); CONV_PHASE(FA, 0); }
        SEAM(P + 7);
        if (INA(8)) { PTRS(); const bf16* WDA = (const bf16*)(ws + WS_WDNA + layer * 3 * MiB); const bf16* WUBt = (const bf16*)(ws + WS_WUPB + layer * 5 * MiB);
            { const QuadResid q{H}; run_gemm(lds, ACT, WDA, 1024, FA, q, G); meta_gemm(lds, ACT, WDA, 1024, FA, q, vcu, G); }
            { const QuadPlain q{UB, 2 * FB}; run_gemm(lds, XN, WUBt, 2 * FB, 1024, q, G); meta_gemm(lds, XN, WUBt, 2 * FB, 1024, q, vcu, G); }
        }
        SEAM(P + 8);
        if (INA(9)) { PTRS(); CONV_PHASE(FB, FA); }
        SEAM(P + 9);
        if (INA(10)) { PTRS(); const bf16* WDBt = (const bf16*)(ws + WS_WDNB + layer * (5 * MiB / 2)); const QuadResid q{H}; run_gemm(lds, ACT, WDBt, 1024, FB, q, G); meta_gemm(lds, ACT, WDBt, 1024, FB, q, vcu, G); }
        SEAM(P + 10);
#undef CONV_PHASE
        if (INA(11)) { PTRS();
            if (layer == 0) {
                for (int r = gw; r < NBATCH * TREAL; r += NGW) { const int b = r / TREAL, pos = r - b * TREAL, row = b * TALLOC + pos;
                    rms_row_bf16(H + (size_t)row * 1024, args.in[IN_DSA_NORM], XN + (size_t)row * 1024, nullptr, lane); }
                for (int r = gw; r < 2 * NBATCH * (TALLOC - TREAL); r += NGW) { const int which = r / (NBATCH * (TALLOC - TREAL)), rr = r % (NBATCH * (TALLOC - TREAL)), b = rr / (TALLOC - TREAL), pos = TREAL + rr % (TALLOC - TREAL);
                    v4u* p = (v4u*)(KB + (size_t)which * QKV_STRIDE + (size_t)(b * TALLOC + pos) * 1024); unsigned z = 0u; asm volatile("" : "+v"(z)); p[lane] = v4u{z, z, z, z}; p[lane + 64] = v4u{z, z, z, z}; }
            } else {
                for (int r = gw; r < NBATCH * SEQL; r += NGW) { const int b = r / SEQL, t = r - b * SEQL;
                    const f32x4* xr = (const f32x4*)(H + (size_t)(b * TALLOC + NMETA + t) * 1024) + lane; f32x4 v[4]; float s = 0.f;
#pragma unroll
                    for (int j = 0; j < 4; ++j) { v[j] = xr[64 * j]; s += (v[j].x * v[j].x + v[j].y * v[j].y) + (v[j].z * v[j].z + v[j].w * v[j].w); }
                    const float rr = 1.0f / sqrtf(wave_sum(s) * (1.f / 1024.f) + RMS_EPS);
                    const f32x4* gr = (const f32x4*)args.in[IN_FINAL_NORM] + lane; f32x4* o = (f32x4*)(args.out + (size_t)r * 1024) + lane;
#pragma unroll
                    for (int j = 0; j < 4; ++j) o[64 * j] = v[j] * rr * gr[64 * j];
                }
            }
        }
        if (layer == 0) SEAM(P + 11);
    }
#undef IN
#undef INA
#undef SEAM
}

#ifndef MK_PER_PHASE
#define MK_PER_PHASE 0
#endif
extern "C" void kernel_launch(void* const* d_in, const int* in_sizes, int n_in, void* d_out, int out_size, void* d_ws, size_t ws_size, hipStream_t stream) {
    static int grid = 0;
    if (grid == 0) {
        if (n_in != 20 || out_size != NBATCH * SEQL * DMODEL || ws_size < WS_END) { fprintf(stderr, "kernel_launch: unexpected problem (n_in %d, out %d, ws %zu)\n", n_in, out_size, ws_size); grid = -1; return; }
        int dev = 0, cus = 0, per_cu = 0;
        if (hipGetDevice(&dev) != hipSuccess || hipDeviceGetAttribute(&cus, hipDeviceAttributeMultiprocessorCount, dev) != hipSuccess) { grid = -1; return; }
        if (hipFuncSetAttribute((const void*)fwd, hipFuncAttributeMaxDynamicSharedMemorySize, LDS_BYTES) != hipSuccess) { fprintf(stderr, "kernel_launch: hipFuncSetAttribute failed\n"); grid = -1; return; }
        if (hipOccupancyMaxActiveBlocksPerMultiprocessor(&per_cu, (const void*)fwd, NWAVES * 64, LDS_BYTES) != hipSuccess || per_cu < 1) { fprintf(stderr, "kernel_launch: occupancy query says %d\n", per_cu); }
        (void)hipGetLastError();
        grid = cus;
    }
    if (grid < 0) return;
    if (hipMemsetAsync((char*)d_ws + WS_CTL, 0, CTL_ZERO_BYTES, stream) != hipSuccess) return;
    Args a{};
    for (int i = 0; i < 20; ++i) a.in[i] = (const float*)d_in[i];
    a.out = (float*)d_out; a.ws = (unsigned char*)d_ws;
#if MK_PER_PHASE
    for (int p = 0; p < N_PHASES; ++p) { if (p == 4) continue; a.ph_lo = p; a.ph_hi = p + 1; hipLaunchKernelGGL(fwd, dim3(grid), dim3(NWAVES * 64), LDS_BYTES, stream, a); }
#else
    a.ph_lo = 0; a.ph_hi = N_PHASES;
    hipLaunchKernelGGL(fwd, dim3(grid), dim3(NWAVES * 64), LDS_BYTES, stream, a);
#endif
}
```

```cpp
#include <hip/hip_runtime.h>
#include <hip/hip_bf16.h>
#include <cstdio>
#include <cstdint>
#include <cmath>
__device__ __forceinline__ int lane_id() { int r; asm volatile("v_mbcnt_lo_u32_b32 %0, -1, 0\n\tv_mbcnt_hi_u32_b32 %0, -1, %0" : "=v"(r)); return r; }
#ifdef DILSEC
#define DILS_B(n) const unsigned long long dils_t0_##n = (DILSEC == (n)) ? __builtin_amdgcn_s_memrealtime() : 0ull
#define DILS_E(n) do { if (DILSEC == (n)) { const unsigned long long t1_ = __builtin_amdgcn_s_memrealtime(), d_ = t1_ - dils_t0_##n; while (__builtin_amdgcn_s_memrealtime() - t1_ < d_) __builtin_amdgcn_s_sleep(2); } } while (0)
#else
#define DILS_B(n)
#define DILS_E(n) do { } while (0)
#endif
namespace pg8 {
#define PG8_LAS __attribute__((address_space(3)))
typedef unsigned short bf16_t;
typedef short bf16x8 __attribute__((ext_vector_type(8)));
typedef float f32x4 __attribute__((ext_vector_type(4)));
typedef unsigned u32x4 __attribute__((ext_vector_type(4)));
constexpr int BM = 256, BK = 64, HALF = 128, HTB = HALF * BK * 2  , STAGE_BYTES = 8 * HTB, NXCD = 8, WGM = 8;

__host__ __device__ __forceinline__ int lds_byte(int r, int c) { const int st = (r >> 4) * 2 + (c >> 5), rr = r & 15, cc = c & 31, ob = rr * 64 + cc * 2; return st * 1024 + (ob ^ (((ob >> 9) & 1) << 5)); }
__host__ __device__ __forceinline__ void stage_rc(int b, int& R, int& C) { const int st = b / 1024, sb = b % 1024, swz = sb ^ (((sb >> 9) & 1) << 5); R = (st >> 1) * 16 + swz / 64; C = (st & 1) * 32 + (swz % 64) / 2; }
__host__ __device__ __forceinline__ int perm32(int rho) { const int n = rho >> 4, i = rho & 15; return 8 * (i >> 2) + 4 * n + (i & 3); }

__host__ __device__ __forceinline__ int arow(int pm) { return (pm >> 6) * 16640 + 16 + ((pm & 63) << 8); }
struct Unit { int pm, pn; };
struct Gemm { const bf16_t* A; const bf16_t* Bt; int M, N, K; };

struct StaticOrder {
    int nM, nN, nwg, G, c;
    __host__ __device__ void init(int M, int N, int G_, int c_) { nM = M / BM; nN = N / BM; nwg = nM * nN; G = G_; c = c_; }
    __host__ __device__ bool next(int i, Unit& u) const {
        const long L = (long)i * G + c; if (L >= nwg) return false;
        int wgid = (int)L; { const int q = nwg / NXCD, r = nwg % NXCD, xcd = wgid % NXCD, off = wgid / NXCD; wgid = (xcd < r ? xcd * (q + 1) : r * (q + 1) + (xcd - r) * q) + off; }
        const int nig = WGM * nN, gid = wgid / nig, fm = gid * WGM, gsz = (nM - fm) < WGM ? (nM - fm) : WGM;
        u.pm = fm + ((wgid % nig) % gsz); u.pn = (wgid % nig) / gsz; return true;
    }
    __device__ __forceinline__ void a_ready(const Unit&) const {}
    __device__ __forceinline__ void done(const Unit&) const {}
};
__device__ __forceinline__ unsigned cvt_pk_bf16(float lo, float hi) { unsigned r; asm volatile("v_cvt_pk_bf16_f32 %0, %1, %2" : "=v"(r) : "v"(lo), "v"(hi)); return r; }
template <class Epi, class Sched, bool ALIGN_EPI = false, bool SP2 = false>
__device__ __forceinline__ void gemm_phase(PG8_LAS unsigned char* lds, const Gemm g, const Sched& S, const Epi& E, const int wv_) {
    int tid_ = wv_ * 64 + lane_id(); asm volatile("" : "+v"(tid_));
    const int tid = tid_, wid = __builtin_amdgcn_readfirstlane(tid >> 6), lane = tid & 63, wr = wid >> 2, wc = wid & 3, fr = lane & 15, fq = lane >> 4;
    const int K = g.K, nt = K / BK;
    unsigned voffA[2], voffB[2];
#pragma unroll
    for (int i = 0; i < 2; ++i) { int R, C; stage_rc(tid * 16 + i * 8192, R, C); const int Rb = Epi::PERM ? ((R & ~31) + perm32(R & 31)) : R;
        voffA[i] = (unsigned)(R * K + C) * 2u; voffB[i] = (unsigned)(Rb * K + C) * 2u; }
    const size_t kstep = (size_t)(BK * 2);
    const size_t hstep = (size_t)HALF * K * 2;
    const size_t tstep = 2 * hstep;
    const unsigned ldsw = (unsigned)wid * 1024u;
    const int aoff = lds_byte(wr * 64 + fr, fq * 8), boff = lds_byte(wc * 32 + fr, fq * 8);
#define PG8_SA(b, h) (((b) * 2 + (h)) * HTB)
#define PG8_SB(b, h) ((4 + (b) * 2 + (h)) * HTB)
#define PG8_STAGE(bufoff, gbase, voff) do { _Pragma("unroll") for (int _i = 0; _i < 2; ++_i) \
        __builtin_amdgcn_global_load_lds((const unsigned*)((const char*)(gbase) + (voff)[_i]), (PG8_LAS unsigned*)(lds + (bufoff) + ldsw + _i * 8192), 16, 0, 0); } while (0)
#define PG8_LDA(dst, b, h) do { _Pragma("unroll") for (int m = 0; m < 4; ++m) _Pragma("unroll") for (int k = 0; k < 2; ++k) dst[m][k] = *(const PG8_LAS bf16x8*)(lds + PG8_SA(b, h) + aoff + m * 2048 + k * 1024); } while (0)
#define PG8_LDB(dst, b, h) do { _Pragma("unroll") for (int n = 0; n < 2; ++n) _Pragma("unroll") for (int k = 0; k < 2; ++k) dst[n][k] = *(const PG8_LAS bf16x8*)(lds + PG8_SB(b, h) + boff + n * 2048 + k * 1024); } while (0)
#define PG8_MMA(ai, bj, At, Bt) do { __builtin_amdgcn_s_setprio(1); _Pragma("unroll") for (int m = 0; m < 4; ++m) _Pragma("unroll") for (int n = 0; n < 2; ++n) _Pragma("unroll") for (int k = 0; k < 2; ++k) \
        acc[ai][bj][m][n] = __builtin_amdgcn_mfma_f32_16x16x32_bf16(Bt[n][k], At[m][k], acc[ai][bj][m][n], 0, 0, 0); __builtin_amdgcn_s_setprio(0); } while (0)
#define PG8_WAIT_V(n) asm volatile("s_waitcnt vmcnt(" #n ")" ::: "memory")
#define PG8_WAIT_L(n) asm volatile("s_waitcnt lgkmcnt(" #n ")" ::: "memory")
#define PG8_BAR __builtin_amdgcn_s_barrier()
#define PG8_SCHED __builtin_amdgcn_sched_barrier(0)
    Unit cur, nxt; int ui = 0;
    if (!S.next(0, cur)) return;
    f32x4 acc[2][2][4][2]; float zf_ = 0.f; asm volatile("" : "+v"(zf_));
#pragma unroll
    for (int a = 0; a < 2; ++a)
#pragma unroll
        for (int b = 0; b < 2; ++b)
#pragma unroll
            for (int m = 0; m < 4; ++m)
#pragma unroll
                for (int n = 0; n < 2; ++n) acc[a][b][m][n] = (f32x4){zf_, zf_, zf_, zf_};
    bf16x8 At[4][2], B0[2][2], B1[2][2];
    const char* cA = (const char*)g.A + (size_t)arow(cur.pm) * K * 2; const char* cB = (const char*)g.Bt + (size_t)cur.pn * tstep;
    S.a_ready(cur);
    if constexpr (SP2) {
        PG8_STAGE(PG8_SB(0, 0), cB, voffB); PG8_STAGE(PG8_SB(0, 1), cB + hstep, voffB); PG8_STAGE(PG8_SA(0, 0), cA, voffA); PG8_STAGE(PG8_SA(0, 1), cA + hstep, voffA);
        if (wr == 1) PG8_BAR;
        PG8_WAIT_V(2); PG8_BAR;
        PG8_STAGE(PG8_SB(1, 0), cB + kstep, voffB); PG8_STAGE(PG8_SA(1, 0), cA + kstep, voffA); PG8_STAGE(PG8_SB(1, 1), cB + hstep + kstep, voffB);
        PG8_WAIT_V(6); PG8_BAR;
    } else {
        PG8_STAGE(PG8_SB(0, 0), cB, voffB); PG8_STAGE(PG8_SA(0, 0), cA, voffA); PG8_STAGE(PG8_SB(0, 1), cB + hstep, voffB); PG8_STAGE(PG8_SA(0, 1), cA + hstep, voffA);
        if (wr == 1) PG8_BAR;
        PG8_WAIT_V(4); PG8_BAR;
        PG8_STAGE(PG8_SB(1, 0), cB + kstep, voffB); PG8_STAGE(PG8_SA(1, 0), cA + kstep, voffA); PG8_STAGE(PG8_SB(1, 1), cB + hstep + kstep, voffB);
        PG8_WAIT_V(6); PG8_BAR;
    }
    for (;;) {
        const bool has_next = S.next(ui + 1, nxt);
        const char* nA = has_next ? (const char*)g.A + (size_t)arow(nxt.pm) * K * 2 : cA; const char* nB = has_next ? (const char*)g.Bt + (size_t)nxt.pn * tstep : cB;
        for (int t = 0; t < nt; t += 2) {
            const bool last = (t == nt - 2);
            const char* a1 = cA + (size_t)(t + 1) * kstep;
            const char* a2 = last ? nA : cA + (size_t)(t + 2) * kstep; const char* b2 = last ? nB : cB + (size_t)(t + 2) * kstep;
            const char* a3 = a2 + kstep; const char* b3 = b2 + kstep;
            if (last && has_next) S.a_ready(nxt);
            if constexpr (SP2) {
            PG8_LDB(B0, 0, 0); PG8_LDB(B1, 0, 1); PG8_SCHED; PG8_LDA(At, 0, 0); PG8_STAGE(PG8_SA(1, 1), a1 + hstep, voffA);
            PG8_WAIT_V(8); PG8_WAIT_L(0); PG8_BAR; PG8_MMA(0, 0, At, B0); PG8_MMA(0, 1, At, B1); PG8_BAR; PG8_SCHED;
            PG8_LDA(At, 0, 1); PG8_STAGE(PG8_SB(0, 0), b2, voffB); PG8_STAGE(PG8_SB(0, 1), b2 + hstep, voffB); PG8_STAGE(PG8_SA(0, 0), a2, voffA);
            PG8_WAIT_V(8); PG8_WAIT_L(0); PG8_BAR; PG8_MMA(1, 0, At, B0); PG8_MMA(1, 1, At, B1); PG8_BAR; PG8_SCHED;
            PG8_LDB(B0, 1, 0); PG8_LDB(B1, 1, 1); PG8_SCHED; PG8_LDA(At, 1, 0); PG8_STAGE(PG8_SA(0, 1), a2 + hstep, voffA);
            PG8_WAIT_V(8); PG8_WAIT_L(0); PG8_BAR; PG8_MMA(0, 0, At, B0); PG8_MMA(0, 1, At, B1); PG8_BAR; PG8_SCHED;
            PG8_LDA(At, 1, 1); PG8_STAGE(PG8_SB(1, 0), b3, voffB); PG8_STAGE(PG8_SB(1, 1), b3 + hstep, voffB); PG8_STAGE(PG8_SA(1, 0), a3, voffA);
            PG8_WAIT_V(8); PG8_WAIT_L(0); PG8_BAR; PG8_MMA(1, 0, At, B0); PG8_MMA(1, 1, At, B1); PG8_BAR; PG8_SCHED;
            } else {
            PG8_LDB(B0, 0, 0); PG8_SCHED; PG8_LDA(At, 0, 0); PG8_STAGE(PG8_SA(1, 1), a1 + hstep, voffA);
            PG8_WAIT_L(8); PG8_BAR; PG8_WAIT_L(0); PG8_MMA(0, 0, At, B0); PG8_BAR; PG8_SCHED;
            PG8_LDB(B1, 0, 1); PG8_STAGE(PG8_SB(0, 0), b2, voffB);
            PG8_BAR; PG8_WAIT_L(0); PG8_MMA(0, 1, At, B1); PG8_BAR;
            PG8_LDA(At, 0, 1); PG8_STAGE(PG8_SA(0, 0), a2, voffA);
            PG8_BAR; PG8_WAIT_L(0); PG8_MMA(1, 0, At, B0); PG8_BAR; PG8_SCHED;
            PG8_STAGE(PG8_SB(0, 1), b2 + hstep, voffB);
            PG8_WAIT_V(6); PG8_BAR; PG8_MMA(1, 1, At, B1); PG8_BAR;
            PG8_LDB(B0, 1, 0); PG8_SCHED; PG8_LDA(At, 1, 0); PG8_STAGE(PG8_SA(0, 1), a2 + hstep, voffA);
            PG8_WAIT_L(8); PG8_BAR; PG8_WAIT_L(0); PG8_MMA(0, 0, At, B0); PG8_BAR; PG8_SCHED;
            PG8_LDB(B1, 1, 1); PG8_STAGE(PG8_SB(1, 0), b3, voffB);
            PG8_BAR; PG8_WAIT_L(0); PG8_MMA(0, 1, At, B1); PG8_BAR;
            PG8_LDA(At, 1, 1); PG8_STAGE(PG8_SA(1, 0), a3, voffA);
            PG8_BAR; PG8_WAIT_L(0); PG8_MMA(1, 0, At, B0); PG8_BAR; PG8_SCHED;
            PG8_STAGE(PG8_SB(1, 1), b3 + hstep, voffB);
            PG8_WAIT_V(6); PG8_BAR; PG8_MMA(1, 1, At, B1); PG8_BAR;
            }
        }
        if constexpr (ALIGN_EPI) { if (wr == 0) PG8_BAR; }
        if constexpr (!Epi::AFTER_DRAIN) { E(acc, cur, wr, wc, fr, fq); S.done(cur); }
        if (!has_next) break;
#pragma unroll
        for (int a = 0; a < 2; ++a)
#pragma unroll
            for (int b = 0; b < 2; ++b)
#pragma unroll
                for (int m = 0; m < 4; ++m)
#pragma unroll
                    for (int n = 0; n < 2; ++n) acc[a][b][m][n] = (f32x4){zf_, zf_, zf_, zf_};
        cur = nxt; cA = nA; cB = nB; ++ui;
        if constexpr (ALIGN_EPI) { if (wr == 1) PG8_BAR; }
    }
    PG8_WAIT_V(0);
    if constexpr (!ALIGN_EPI) { if (wr == 0) PG8_BAR; }
    PG8_BAR;
    if constexpr (Epi::AFTER_DRAIN) { E.fused(acc, cur, wr, wc, fr, fq, lds, wid, lane); S.done(cur); }
#undef PG8_SA
#undef PG8_SB
#undef PG8_STAGE
#undef PG8_LDA
#undef PG8_LDB
#undef PG8_MMA
#undef PG8_WAIT_V
#undef PG8_WAIT_L
#undef PG8_BAR
#undef PG8_SCHED
}
}

namespace attn_body {
using bf16=__hip_bfloat16;
using bf16x8=__attribute__((ext_vector_type(8)))short;
using s16x4=__attribute__((ext_vector_type(4)))short;
using f32x16=__attribute__((ext_vector_type(16)))float;
using u32x4=__attribute__((ext_vector_type(4)))unsigned;
constexpr int SEQ=16640,TREAL=16400,D=64,DM=1024;
constexpr int NW=8,QBLK=32,QB=QBLK*NW,KVBLK=64,NQB=SEQ/QB;
constexpr int ATTN_PITCH=DM, ATTN_UNIT_ROWS=QB;
__device__ __forceinline__ int crow(int r,int hi){return (r&3)+8*(r>>2)+4*hi;}
#define SBAR() __builtin_amdgcn_sched_barrier(0)
typedef unsigned u32x2 __attribute__((ext_vector_type(2)));
__device__ __forceinline__ void mmask(f32x16&p0,f32x16&p1,unsigned w0,unsigned w1,int hi,float nmh){
  const float NEG=-INFINITY; const unsigned a=w0>>(4*hi), b=w1>>(4*hi);
  #pragma unroll
  for(int r=0;r<16;++r){const int c=(r&3)+8*(r>>2); p0[r]=((a>>c)&1u)?p0[r]+nmh:NEG; p1[r]=((b>>c)&1u)?p1[r]+nmh:NEG;}
}
__device__ __forceinline__ void cmask(f32x16&p0,f32x16&p1,int jb,int qrel,int hi){
  const float NEG=-INFINITY; int kb=64*jb+4*hi;
  #pragma unroll
  for(int r=0;r<16;++r){int kv=kb+(r&3)+8*(r>>2); if(kv>qrel)p0[r]=NEG; if(kv+32>qrel)p1[r]=NEG;}
}

constexpr int NSLOT=3, SLOTB=8192;
constexpr int VSLOTB=2*SLOTB;
constexpr int LDS_K=0, LDS_V=NSLOT*SLOTB, LDS_WS=LDS_V+NSLOT*VSLOTB, LDS_OST=LDS_WS+NW*64*4, LDS_MK=LDS_OST+NW*4096, LDS_BYTES=LDS_MK+NW*2048;
constexpr float C2=0.125f*1.4426950408889634f;
__device__ __forceinline__ void glds16(const void*gsrc,unsigned lds_dst){unsigned keep;
  asm volatile("s_mov_b32 %0, m0\n\ts_mov_b32 m0, %2\n\ts_nop 0\n\tglobal_load_lds_dwordx4 %1, off\n\ts_mov_b32 m0, %0":"=&s"(keep):"v"(gsrc),"s"(lds_dst):"memory");}
__device__ __forceinline__ float max3f(float a,float b,float c){float r;asm("v_max3_f32 %0, %1, %2, %3":"=v"(r):"v"(a),"v"(b),"v"(c));return r;}
__device__ __forceinline__ float max2f(float a,float b){float r;asm("v_max_f32_e32 %0, %1, %2":"=v"(r):"v"(a),"v"(b));return r;}
__device__ __forceinline__ float fadd_s(float a,float b){float r;asm("v_add_f32_e32 %0, %1, %2":"=v"(r):"v"(a),"v"(b));return r;}
__device__ __forceinline__ float fsub_s(float a,float b){float r;asm("v_sub_f32_e32 %0, %1, %2":"=v"(r):"v"(a),"v"(b));return r;}
typedef float f32x2_t __attribute__((ext_vector_type(2))); typedef __bf16 bf16x2_t __attribute__((ext_vector_type(2)));
__device__ __forceinline__ unsigned cvtpk_s(float lo,float hi){f32x2_t v={lo,hi};bf16x2_t b=__builtin_convertvector(v,bf16x2_t);return __builtin_bit_cast(unsigned,b);}
#define WAIT_BAR(N) asm volatile("s_waitcnt vmcnt(" #N ") lgkmcnt(0)\n\ts_barrier":::"memory")

__device__ __forceinline__ void qkt(f32x16&p0,f32x16&p1,const char*Kslot,const bf16x8*qr,const f32x16&negm,int r32,int hi){
  const char*kb=Kslot+hi*1024+r32*16;
  #pragma unroll
  for(int d0=0;d0<4;++d0){
    const bf16x8 b0=*reinterpret_cast<const bf16x8*>(kb+d0*2048);
    const bf16x8 b1=*reinterpret_cast<const bf16x8*>(kb+d0*2048+512);
    if(d0==0){p0=__builtin_amdgcn_mfma_f32_32x32x16_bf16(b0,qr[0],negm,0,0,0);p1=__builtin_amdgcn_mfma_f32_32x32x16_bf16(b1,qr[0],negm,0,0,0);}
    else{p0=__builtin_amdgcn_mfma_f32_32x32x16_bf16(b0,qr[d0],p0,0,0,0);p1=__builtin_amdgcn_mfma_f32_32x32x16_bf16(b1,qr[d0],p1,0,0,0);}}
}
typedef __attribute__((address_space(3))) const char* lds_cptr;
typedef short v4i16_t __attribute__((ext_vector_type(4)));
__device__ __forceinline__ void kload8(bf16x8*kf,lds_cptr kp){
  kf[0]=*(const __attribute__((address_space(3))) bf16x8*)(kp);      kf[1]=*(const __attribute__((address_space(3))) bf16x8*)(kp+512);
  kf[2]=*(const __attribute__((address_space(3))) bf16x8*)(kp+2048); kf[3]=*(const __attribute__((address_space(3))) bf16x8*)(kp+2560);
  kf[4]=*(const __attribute__((address_space(3))) bf16x8*)(kp+4096); kf[5]=*(const __attribute__((address_space(3))) bf16x8*)(kp+4608);
  kf[6]=*(const __attribute__((address_space(3))) bf16x8*)(kp+6144); kf[7]=*(const __attribute__((address_space(3))) bf16x8*)(kp+6656);
}
__device__ __forceinline__ void kload2(bf16x8*kf,lds_cptr kp,int j){ kf[2*j]=*(const __attribute__((address_space(3))) bf16x8*)(kp+j*2048); kf[2*j+1]=*(const __attribute__((address_space(3))) bf16x8*)(kp+j*2048+512); }
__device__ __forceinline__ s16x4 vtr(lds_cptr p){ return __builtin_bit_cast(s16x4,__builtin_amdgcn_ds_read_tr16_b64_v4i16((__attribute__((address_space(3))) v4i16_t*)p)); }
__device__ __forceinline__ float rowmax(const f32x16&p0,const f32x16&p1){
  float a=max3f(p0[0],p0[1],p1[0]),b=max3f(p0[2],p0[3],p1[1]);a=max3f(a,p1[2],p1[3]);
  #pragma unroll
  for(int r=4;r<16;r+=4){a=max3f(a,p0[r],p0[r+1]);b=max3f(b,p0[r+2],p0[r+3]);a=max3f(a,p1[r],p1[r+1]);b=max3f(b,p1[r+2],p1[r+3]);}
  const float m=max2f(a,b);
  auto rr=__builtin_amdgcn_permlane32_swap(__float_as_uint(m),__float_as_uint(m),false,false);
  return max2f(__uint_as_float(rr[0]),__uint_as_float(rr[1]));
}
__device__ __forceinline__ void pv(f32x16*o,int vb,bf16x8 pa0,bf16x8 pa1,bf16x8 pa2,bf16x8 pa3){
  #pragma unroll
  for(int d0=0;d0<2;++d0){s16x4 lo[4],hi[4];
    #pragma unroll
    for(int ks=0;ks<4;++ks){
      asm volatile("ds_read_b64_tr_b16 %0,%1 offset:%c2":"=&v"(lo[ks]):"v"(vb),"i"(d0*4096+ks*1024):"memory");
      asm volatile("ds_read_b64_tr_b16 %0,%1 offset:%c2":"=&v"(hi[ks]):"v"(vb),"i"(d0*4096+ks*1024+512):"memory");}
    asm volatile("s_waitcnt lgkmcnt(0)":::"memory");SBAR();
    #define PK(k) (bf16x8){lo[k][0],lo[k][1],lo[k][2],lo[k][3],hi[k][0],hi[k][1],hi[k][2],hi[k][3]}
    o[d0]=__builtin_amdgcn_mfma_f32_32x32x16_bf16(pa0,PK(0),o[d0],0,0,0);
    o[d0]=__builtin_amdgcn_mfma_f32_32x32x16_bf16(pa1,PK(1),o[d0],0,0,0);
    o[d0]=__builtin_amdgcn_mfma_f32_32x32x16_bf16(pa2,PK(2),o[d0],0,0,0);
    o[d0]=__builtin_amdgcn_mfma_f32_32x32x16_bf16(pa3,PK(3),o[d0],0,0,0);
    #undef PK
  }
}

#ifndef ATTN_STORE16
#define ATTN_STORE16(p,v) (*(u32x4*)(p)=(v))
#endif
template<int THRL,bool MASKED,int VW> __device__ __forceinline__ void attn_unit(int b,int hq,int hv,int qb,const bf16*Q,const bf16*__restrict__ K,const bf16*__restrict__ V,bf16*O,const unsigned*__restrict__ MK,char*shm,const int wv_){
  int tid_=wv_*64+lane_id(); asm volatile("":"+v"(tid_));
  const int tid=tid_,lane=tid&63,r32=lane&31,hi=lane>>5; const int wid=__builtin_amdgcn_readfirstlane(tid>>6);
  const long rowbase=(long)b*SEQ; const int q0=qb*QB;
  const bf16*Qw=Q+(rowbase+q0+wid*QBLK)*DM+hq*D;
  const bf16*Kh=K+rowbase*DM+hq*D,*Vh=V+rowbase*DM+hv*D;
  const unsigned lds0=(unsigned)(uintptr_t)shm;
  float*wsf=(float*)(shm+LDS_WS)+wid*64;
  const bf16*ksrc=Kh+(long)lane*DM+wid*8;
  const bf16*vsrc=Vh+(long)(16*(wid&3)+(lane>>2))*DM+(wid>>2)*32+(lane&3)*8;
  const unsigned kdst=lds0+LDS_K+wid*1024, vdst=lds0+LDS_V+wid*1024;
  #define DMA_K(t,slot) glds16(ksrc+(long)(t)*KVBLK*DM,(unsigned)__builtin_amdgcn_readfirstlane(kdst+(slot)))
  #define DMA_V(t,slot) do{ glds16(vsrc+(long)(t)*KVBLK*DM,(unsigned)__builtin_amdgcn_readfirstlane(vdst+2*(slot))); if(VW==2){glds16(vsrc+64+(long)(t)*KVBLK*DM,(unsigned)__builtin_amdgcn_readfirstlane(vdst+8192+2*(slot)));} }while(0)
  const int vb0=(int)(lds0+LDS_V)+((lane>>4)&1)*32+(lane&3)*8+(4*hi+((lane&15)>>2))*64;
  const char*Kbase=shm+LDS_K; bf16x8 kf[8];
  const lds_cptr shm3=(lds_cptr)shm; const lds_cptr kp0=shm3+LDS_K+hi*1024+r32*16; const lds_cptr vp0=shm3+LDS_V+((lane>>4)&1)*32+(lane&3)*8+(4*hi+((lane&15)>>2))*64;
  const int NT=(q0+QB)/KVBLK;
  constexpr bool NEGM_=VW==1;
  const unsigned*msrc=MK+((rowbase+q0+wid*QBLK+r32)*520+4*hi); const unsigned mdst=lds0+LDS_MK+wid*2048; const lds_cptr mp0=(lds_cptr)shm+LDS_MK+wid*2048+r32*16;
  #define DMA_M(j) glds16(msrc+8*(j),(unsigned)__builtin_amdgcn_readfirstlane(mdst+(((j)&1)*1024)))
  unsigned mka_=0u,mkb_=0u;
  #define MMASK(P0,P1,t) do{ if(MASKED){ const u32x2 mw_=*(const __attribute__((address_space(3))) u32x2*)(mp0+((((t)>>2)&1)*1024+(((t)>>1)&1)*512+((t)&1)*8)); mka_=mw_.x>>(4*hi); mkb_=mw_.y>>(4*hi);} }while(0)
  #define MSEL(X,r,MK) do{ if(MASKED){ X[r]=__uint_as_float(__float_as_uint(X[r])&(unsigned)__builtin_amdgcn_sbfe((int)(MK),((r)&3)+8*((r)>>2),1)); } }while(0)
  if(MASKED){DMA_M(0);}
  DMA_K(0,0);DMA_V(0,0);DMA_K(1,SLOTB);
  bf16x8 qr[4];
  #pragma unroll
  for(int d0=0;d0<4;++d0)qr[d0]=*reinterpret_cast<const bf16x8*>(&Qw[(long)r32*DM+d0*16+hi*8]);
  constexpr bool QLDS=VW==2||MASKED;
  const lds_cptr qst=(lds_cptr)shm+LDS_OST+wid*4096+lane*16;
  if(QLDS){ _Pragma("unroll") for(int d0=0;d0<4;++d0) *(__attribute__((address_space(3))) bf16x8*)((__attribute__((address_space(3))) char*)(qst+d0*1024))=qr[d0]; }
  #define QF(d0) (QLDS?*(const __attribute__((address_space(3))) bf16x8*)(qst+(d0)*1024):qr[d0])
  float mhat=0.f,l_reg=0.f;constexpr bool NEGM=VW==1;
  float zf_=0.f; asm volatile("":"+v"(zf_)); const f32x16 zv_={zf_,zf_,zf_,zf_,zf_,zf_,zf_,zf_,zf_,zf_,zf_,zf_,zf_,zf_,zf_,zf_};
  f32x16 o[2*VW];_Pragma("unroll") for(int i_=0;i_<2*VW;++i_)o[i_]=zv_;f32x16 negm=zv_;if(NEGM){asm volatile("":"+v"(negm));}
  const int qrel=wid*QBLK+r32;
  #define CMASK(P0,P1,t) do{ if(!MASKED){int jb_=(t)-(NT-4); if(jb_>=0)cmask(P0,P1,jb_,qrel,hi);} MMASK(P0,P1,t); }while(0)
  bool resc=false;
  #define START(P0,P1) do{ const float rm=rowmax(P0,P1); resc=false; \
    { const float dl=(VW==2&&__builtin_fabsf(rm)<=(float)THRL)?0.f:rm;     \
      mhat=fadd_s(mhat,dl); \
      _Pragma("unroll") for(int r=0;r<16;++r){P0[r]=fsub_s(P0[r],dl);P1[r]=fsub_s(P1[r],dl);} \
      if(NEGM){_Pragma("unroll") for(int r=0;r<16;++r)negm[r]=-mhat; asm volatile("":"+v"(negm));} } \
    _Pragma("unroll") for(int r=0;r<16;++r){P0[r]=__builtin_amdgcn_exp2f(P0[r]); MSEL(P0,r,mka_);} }while(0)
  #define RESC() do{ if(resc){ asm volatile("s_waitcnt lgkmcnt(0)":::"memory"); \
      _Pragma("unroll") for(int d_=0;d_<2*VW;++d_) _Pragma("unroll") for(int r=0;r<16;++r)o[d_][r]*=wsf[crow(r,hi)]; } }while(0)
  f32x16 pA0,pA1,pB0,pB1;
  int sl_prev=0,sl_cur=0,sl_next=SLOTB;
  #define ROT() do{sl_prev=sl_cur;sl_cur=sl_next;sl_next=(sl_next==(NSLOT-1)*SLOTB)?0:sl_next+SLOTB;}while(0)
  DMA_K(2,2*SLOTB);
  WAIT_BAR(3);
  qkt(pA0,pA1,Kbase,qr,negm,r32,hi);asm volatile("s_nop 15\n\ts_nop 7":"+v"(pA0),"+v"(pA1));CMASK(pA0,pA1,0);
  START(pA0,pA1);
  _Pragma("unroll") for(int r=0;r<16;++r){pA1[r]=__builtin_amdgcn_exp2f(pA1[r]); MSEL(pA1,r,mkb_);}
  WAIT_BAR(0);
  DMA_K(3,0);DMA_V(1,SLOTB);
  ROT();
  kload8(kf,kp0+sl_cur);
  if(VW==2){WAIT_BAR(3);}else{WAIT_BAR(2);}
  s16x4 vlo[8],vhi[8]; u32x4 pw0,pw1,pw2,pw3;
  #define PKW(P,B) cvtpk_s(P[B],P[B+1])
  #define PAF(k) __builtin_bit_cast(bf16x8,pw##k)
  #define VFR(i) (bf16x8){vlo[i][0],vlo[i][1],vlo[i][2],vlo[i][3],vhi[i][0],vhi[i][1],vhi[i][2],vhi[i][3]}
  #define PIN(x) asm volatile("":"+v"(x))
  #define MX3(a,b,c) __builtin_fmaxf(__builtin_fmaxf((a),(b)),(c))
  #define GAPA(MF,A0,A1,A2,A3,W0,W1,PW) do{ MF; sacc+=A0; sacc+=A1; sacc+=A2; sacc+=A3; PIN(sacc); W0; W1; PIN(PW); SBAR(); }while(0)
  #define EX(v) __builtin_amdgcn_exp2f(v)
  #define GAPB(MF,X,B) do{ MF; X[B]=EX(X[B]); X[B+1]=EX(X[B+1]); X[B+2]=EX(X[B+2]); X[B+3]=EX(X[B+3]); PIN(X); SBAR(); }while(0)
  #define VRD(i) do{ vlo[i]=vtr(vp_+(((i)>>2)*4096+((i)&3)*1024)); vhi[i]=vtr(vp_+(((i)>>2)*4096+((i)&3)*1024+512)); }while(0)
  #define KRD(G,j) do{ if(G){ kload2(kf,kp0+sl_next,j); SBAR(); } }while(0)
  #define VRD2(i) do{ if(VW==2){ vlo[i]=vtr(vp_+(8192+((i)>>2)*4096+((i)&3)*1024)); vhi[i]=vtr(vp_+(8192+((i)>>2)*4096+((i)&3)*1024+512)); } }while(0)
  #define GAPB2(MF,X,B,VI,MK) do{ MF; VRD2(VI); X[B]=EX(X[B]); X[B+1]=EX(X[B+1]); X[B+2]=EX(X[B+2]); X[B+3]=EX(X[B+3]); MSEL(X,B,MK); MSEL(X,B+1,MK); MSEL(X,B+2,MK); MSEL(X,B+3,MK); PIN(X); SBAR(); }while(0)
  const f32x16 zero16_=f32x16{};
  #define CIN (NEGM?negm:zero16_)
  #define STEP(C0,C1,P0,P1,t,GK,GV,GL) do{ SBAR(); \
    const lds_cptr vp_=vp0+2*sl_prev; bf16x8 qt_; \
    VRD(0); SBAR(); float sacc=(P0[0]+P0[1]); \
    GAPA(C0=__builtin_amdgcn_mfma_f32_32x32x16_bf16(kf[0],(qt_=QF(0)),CIN,0,0,0), P0[2],P0[3],P0[4],P0[5],     pw0[0]=PKW(P0,0), pw0[1]=PKW(P0,2), pw0); \
    VRD(4); SBAR(); GAPA(C1=__builtin_amdgcn_mfma_f32_32x32x16_bf16(kf[1],qt_,CIN,0,0,0), P0[6],P0[7],P0[8],P0[9],     pw0[2]=PKW(P0,4), pw0[3]=PKW(P0,6), pw0); \
    VRD(1); SBAR(); GAPA(C0=__builtin_amdgcn_mfma_f32_32x32x16_bf16(kf[2],(qt_=QF(1)),C0,0,0,0),   P0[10],P0[11],P0[12],P0[13], pw1[0]=PKW(P0,8), pw1[1]=PKW(P0,10), pw1); \
    VRD(5); SBAR(); GAPA(C1=__builtin_amdgcn_mfma_f32_32x32x16_bf16(kf[3],qt_,C1,0,0,0),   P0[14],P0[15],P1[0],P1[1],   pw1[2]=PKW(P0,12),pw1[3]=PKW(P0,14), pw1); \
    VRD(2); SBAR(); GAPA(C0=__builtin_amdgcn_mfma_f32_32x32x16_bf16(kf[4],(qt_=QF(2)),C0,0,0,0),   P1[2],P1[3],P1[4],P1[5],     pw2[0]=PKW(P1,0), pw2[1]=PKW(P1,2), pw2); \
    VRD(6); SBAR(); GAPA(C1=__builtin_amdgcn_mfma_f32_32x32x16_bf16(kf[5],qt_,C1,0,0,0),   P1[6],P1[7],P1[8],P1[9],     pw2[2]=PKW(P1,4), pw2[3]=PKW(P1,6), pw2); \
    VRD(3); SBAR(); GAPA(C0=__builtin_amdgcn_mfma_f32_32x32x16_bf16(kf[6],(qt_=QF(3)),C0,0,0,0),   P1[10],P1[11],P1[12],P1[13], pw3[0]=PKW(P1,8), pw3[1]=PKW(P1,10), pw3); \
    VRD(7); SBAR(); GAPA(C1=__builtin_amdgcn_mfma_f32_32x32x16_bf16(kf[7],qt_,C1,0,0,0),   P1[14],P1[15],0.f,0.f,       pw3[2]=PKW(P1,12),pw3[3]=PKW(P1,14), pw3); \
    l_reg+=sacc; \
    if(MASKED&&(((t)&3)==2)&&((t)+2<NT)){DMA_M(((t)+2)>>2);} if(GK){DMA_K((t)+3,sl_cur);} if(GV){DMA_V((t)+1,sl_next);} \
    CMASK(C0,C1,t); \
    if(!NEGM&&!MASKED){ if(__any(mhat!=0.f)){ _Pragma("unroll") for(int r=0;r<16;++r){C0[r]-=mhat;C1[r]-=mhat;} } } \
    { float a=MX3(C0[0],C0[1],C1[0]),b=MX3(C0[2],C0[3],C1[1]); a=MX3(a,C1[2],C1[3]); \
      _Pragma("unroll") for(int r=4;r<16;r+=4){a=MX3(a,C0[r],C0[r+1]);b=MX3(b,C0[r+2],C0[r+3]);a=MX3(a,C1[r],C1[r+1]);b=MX3(b,C1[r+2],C1[r+3]);} \
      float rm=__builtin_fmaxf(a,b); { auto rr=__builtin_amdgcn_permlane32_swap(__float_as_uint(rm),__float_as_uint(rm),false,false); rm=__builtin_fmaxf(__uint_as_float(rr[0]),__uint_as_float(rr[1])); } \
      resc=false; \
      if(__builtin_expect(__any(rm>(float)THRL),0)){ const float dl=__builtin_fmaxf(rm,0.f); mhat+=dl; \
        _Pragma("unroll") for(int r=0;r<16;++r){C0[r]-=dl;C1[r]-=dl;} \
        if(NEGM){_Pragma("unroll") for(int r=0;r<16;++r)negm[r]=-mhat; asm volatile("":"+v"(negm));} \
        const float f=__builtin_amdgcn_exp2f(-dl); l_reg*=f; if(hi==0)wsf[r32]=f; resc=true; } } \
    SBAR(); \
    GAPB2(o[0]=__builtin_amdgcn_mfma_f32_32x32x16_bf16(PAF(0),VFR(0),o[0],0,0,0), C0,0, 0,mka_); \
    GAPB2(o[1]=__builtin_amdgcn_mfma_f32_32x32x16_bf16(PAF(0),VFR(4),o[1],0,0,0), C0,4, 4,mka_); \
    KRD(GL,0); GAPB2(o[0]=__builtin_amdgcn_mfma_f32_32x32x16_bf16(PAF(1),VFR(1),o[0],0,0,0), C0,8, 1,mka_); \
    KRD(GL,1); GAPB2(o[1]=__builtin_amdgcn_mfma_f32_32x32x16_bf16(PAF(1),VFR(5),o[1],0,0,0), C0,12, 5,mka_); \
    KRD(GL,2); GAPB2(o[0]=__builtin_amdgcn_mfma_f32_32x32x16_bf16(PAF(2),VFR(2),o[0],0,0,0), C1,0, 2,mkb_); \
    KRD(GL,3); GAPB2(o[1]=__builtin_amdgcn_mfma_f32_32x32x16_bf16(PAF(2),VFR(6),o[1],0,0,0), C1,4, 6,mkb_); \
    GAPB2(o[0]=__builtin_amdgcn_mfma_f32_32x32x16_bf16(PAF(3),VFR(3),o[0],0,0,0), C1,8, 3,mkb_); \
    GAPB2(o[1]=__builtin_amdgcn_mfma_f32_32x32x16_bf16(PAF(3),VFR(7),o[1],0,0,0), C1,12, 7,mkb_); \
    if(VW==2){   \
      o[2*VW-2]=__builtin_amdgcn_mfma_f32_32x32x16_bf16(PAF(0),VFR(0),o[2*VW-2],0,0,0); o[2*VW-1]=__builtin_amdgcn_mfma_f32_32x32x16_bf16(PAF(0),VFR(4),o[2*VW-1],0,0,0); \
      o[2*VW-2]=__builtin_amdgcn_mfma_f32_32x32x16_bf16(PAF(1),VFR(1),o[2*VW-2],0,0,0); o[2*VW-1]=__builtin_amdgcn_mfma_f32_32x32x16_bf16(PAF(1),VFR(5),o[2*VW-1],0,0,0); \
      o[2*VW-2]=__builtin_amdgcn_mfma_f32_32x32x16_bf16(PAF(2),VFR(2),o[2*VW-2],0,0,0); o[2*VW-1]=__builtin_amdgcn_mfma_f32_32x32x16_bf16(PAF(2),VFR(6),o[2*VW-1],0,0,0); \
      o[2*VW-2]=__builtin_amdgcn_mfma_f32_32x32x16_bf16(PAF(3),VFR(3),o[2*VW-2],0,0,0); o[2*VW-1]=__builtin_amdgcn_mfma_f32_32x32x16_bf16(PAF(3),VFR(7),o[2*VW-1],0,0,0); SBAR(); } \
    }while(0)
  int t=1;
  #undef CMASK
  #define CMASK(P0,P1,t) MMASK(P0,P1,t)
  for(;t+5<NT;t+=2){
    STEP(pB0,pB1,pA0,pA1,t,true,true,true);     if(VW==2){WAIT_BAR(3);}else{WAIT_BAR(2);} RESC(); ROT();
    STEP(pA0,pA1,pB0,pB1,t+1,true,true,true);   if(VW==2){WAIT_BAR(3);}else{WAIT_BAR(2);} RESC(); ROT();
  }
  #undef CMASK
  #define CMASK(P0,P1,t) do{ if(!MASKED){int jb_=(t)-(NT-4); if(jb_>=0)cmask(P0,P1,jb_,qrel,hi);} MMASK(P0,P1,t); }while(0)
  #define ENDW(tt) do{ if((tt)+3<NT){ if(VW==2){WAIT_BAR(3);}else{WAIT_BAR(2);} } else if((tt)+2<NT){ if(VW==2){WAIT_BAR(2);}else{WAIT_BAR(1);} } else {WAIT_BAR(0);} }while(0)
  for(;t+1<NT;t+=2){
    STEP(pB0,pB1,pA0,pA1,t,(t+3<NT),(t+1<NT),(t+1<NT));       ENDW(t);   RESC(); ROT();
    STEP(pA0,pA1,pB0,pB1,t+1,(t+4<NT),(t+2<NT),(t+2<NT));     ENDW(t+1); RESC(); ROT();
  }
  STEP(pB0,pB1,pA0,pA1,NT-1,false,false,false); RESC();
  { float sacc=pB0[0]+pB0[1]; _Pragma("unroll") for(int r=2;r<16;++r)sacc+=pB0[r]; _Pragma("unroll") for(int r=0;r<16;++r)sacc+=pB1[r]; l_reg+=sacc;
    pw0=(u32x4){PKW(pB0,0),PKW(pB0,2),PKW(pB0,4),PKW(pB0,6)};pw1=(u32x4){PKW(pB0,8),PKW(pB0,10),PKW(pB0,12),PKW(pB0,14)};pw2=(u32x4){PKW(pB1,0),PKW(pB1,2),PKW(pB1,4),PKW(pB1,6)};pw3=(u32x4){PKW(pB1,8),PKW(pB1,10),PKW(pB1,12),PKW(pB1,14)};
    SBAR(); pv(o,vb0+2*sl_cur,PAF(0),PAF(1),PAF(2),PAF(3)); if(VW==2){pv(o+2*VW-2,vb0+2*sl_cur+8192,PAF(0),PAF(1),PAF(2),PAF(3));} }
  #undef PKW
  #undef PAF
  #undef VFR
  #undef PIN
  #undef MX3
  #undef GAPA
  #undef GAPB
  #undef EX
  #undef VRD
  #undef KRD
  #undef QF
  #undef VRD2
  #undef GAPB2
  #undef STEP
  #undef ENDW
  {auto rr=__builtin_amdgcn_permlane32_swap(__float_as_uint(l_reg),__float_as_uint(l_reg),false,false);l_reg=__uint_as_float(rr[0])+__uint_as_float(rr[1]);}
  if(hi==0)wsf[32+r32]=l_reg;asm volatile("s_waitcnt lgkmcnt(0)":::"memory");
  float rli[16];
  #pragma unroll
  for(int r=0;r<16;++r)rli[r]=__builtin_amdgcn_rcpf(wsf[32+crow(r,hi)]);
  bf16*Ow=O+(rowbase+q0+wid*QBLK)*DM+hv*D;
  { bf16*stg=(bf16*)(shm+LDS_OST)+wid*2048;
    #pragma unroll
    for(int e_=0;e_<VW;++e_){
    #pragma unroll
    for(int r=0;r<16;++r){const int orow=crow(r,hi);
      #pragma unroll
      for(int d0=0;d0<2;++d0)((unsigned short*)stg)[orow*64+d0*32+r32]=(unsigned short)cvtpk_s(o[2*e_+d0][r]*rli[r],0.f);}
    asm volatile("s_waitcnt lgkmcnt(0)":::"memory");
    #pragma unroll
    for(int i=0;i<4;++i){const int row=i*8+(lane>>3),ch=lane&7; const u32x4 v=*(const u32x4*)(stg+row*64+ch*8); if(q0+wid*QBLK+row<TREAL){ATTN_STORE16(Ow+(long)row*DM+64*e_+ch*8,v);}}
    asm volatile("s_waitcnt lgkmcnt(0)":::"memory"); } }
  asm volatile("s_waitcnt lgkmcnt(0)\n\ts_barrier":::"memory");
  #undef DMA_K
  #undef DMA_V
  #undef DMA_M
  #undef MMASK
  #undef MSEL
  #undef CMASK
  #undef START
  #undef RESC
  #undef ROT
}
constexpr int ATTN_LDS_BYTES=LDS_BYTES;
#undef SBAR
#undef WAIT_BAR
}

#define GAS __attribute__((address_space(1)))
#define LAS __attribute__((address_space(3)))
typedef unsigned short bf16;
typedef unsigned v4u __attribute__((ext_vector_type(4)));
typedef float f32x4 __attribute__((ext_vector_type(4)));
typedef short bf16x8 __attribute__((ext_vector_type(8)));
typedef GAS unsigned gu32;
typedef GAS unsigned long long gu64;
#define RLX_AGENT __ATOMIC_RELAXED, __HIP_MEMORY_SCOPE_AGENT
#define LDS_WAIT() asm volatile("s_waitcnt lgkmcnt(0)" ::: "memory")
#define VM_WAIT() asm volatile("s_waitcnt vmcnt(0)" ::: "memory")
__device__ __forceinline__ unsigned long long rt() { return __builtin_amdgcn_s_memrealtime(); }
__device__ __forceinline__ unsigned f2bf(float f) { unsigned u = __builtin_bit_cast(unsigned, f); return (u + 0x7fffu + ((u >> 16) & 1u)) >> 16; }
typedef float pk2_f32x2_ __attribute__((ext_vector_type(2))); typedef __bf16 pk2_bf16x2_ __attribute__((ext_vector_type(2)));
__device__ __forceinline__ unsigned pk2(float lo, float hi) { pk2_f32x2_ v = {lo, hi}; pk2_bf16x2_ b = __builtin_convertvector(v, pk2_bf16x2_); return __builtin_bit_cast(unsigned, b); }

#define XB_TMO      128
#define XB_XCNT(j)  (256  + 64 * (j))
#define XB_XSUB(j)  (1280 + 64 * (j))
#define XB_XGEN(j)  (2304 + 64 * (j))
#define XB_TOP      3328
#define XB_TOPGEN   3392
#define XCD_BAR_WORDS 3456
#define XB_SPIN_CAP (1u << 22)

__device__ __forceinline__ unsigned xb_ld(unsigned* p)              { return __hip_atomic_load(p, __ATOMIC_RELAXED, __HIP_MEMORY_SCOPE_AGENT); }
__device__ __forceinline__ unsigned xb_add(unsigned* p, unsigned v) { return __hip_atomic_fetch_add(p, v, __ATOMIC_RELAXED, __HIP_MEMORY_SCOPE_AGENT); }
__device__ __forceinline__ unsigned xb_xcc_id() { return (unsigned)__builtin_amdgcn_s_getreg((3 << 11) | 20) & 0xFu; }
#define XB_SPIN(cond, bar) do { unsigned _sp = 0; while (cond) { __builtin_amdgcn_s_sleep(1); \
    if ((++_sp & 255u) == 0u) { if (xb_ld(&(bar)[XB_TMO])) break; if (_sp > XB_SPIN_CAP) { atomicAdd(&(bar)[XB_TMO], 1u); break; } } } } while (0)

struct XcdBarrier {
    unsigned* bar; unsigned x;
    volatile LAS unsigned* st;
};

__device__ __forceinline__ XcdBarrier xcd_barrier_post(unsigned* bar, volatile LAS unsigned* st, const int wv_) {
    XcdBarrier b; b.bar = bar; b.x = xb_xcc_id(); b.st = st;
    if (wv_ == 0 && lane_id() == 0) (void)xb_add(&bar[XB_XCNT(b.x)], 1u);
    return b;
}
__device__ __forceinline__ void xcd_barrier_complete(unsigned* bar, unsigned x, unsigned& nloc, unsigned& nx) {
    const unsigned G = gridDim.x * gridDim.y * gridDim.z;
    unsigned sum, cnt, mine, sp = 0u;
    for (;;) {
        sum = 0u; cnt = 0u; mine = 0u;
#pragma unroll
        for (unsigned j = 0; j < 16; ++j) { const unsigned c = xb_ld(&bar[XB_XCNT(j)]); sum += c; cnt += (c > 0u) ? 1u : 0u; mine = (j == x) ? c : mine; }
        if (sum == G) break;
        __builtin_amdgcn_s_sleep(1);
        if ((++sp & 255u) == 0u) { if (xb_ld(&bar[XB_TMO])) break; if (sp > XB_SPIN_CAP) { atomicAdd(&bar[XB_TMO], 1u); break; } }
    }
    nloc = mine > 0u ? mine : 1u; nx = cnt > 0u ? cnt : 1u;
}

__device__ __forceinline__ void xcd_barrier(const XcdBarrier& b, const int wv_) {
    asm volatile("s_waitcnt vmcnt(0)" ::: "memory");
    __syncthreads();
    if (wv_ == 0 && lane_id() == 0) {
        unsigned* bar = b.bar;
        __builtin_amdgcn_s_waitcnt(0);
        unsigned nloc = b.st[0], nx = b.st[1];
        if (nloc == 0u) { xcd_barrier_complete(bar, b.x, nloc, nx); b.st[0] = nloc; b.st[1] = nx; }
        const unsigned old = xb_add(&bar[XB_XSUB(b.x)], 1u);
        const unsigned gen = old / nloc;
        if (old + 1u == (gen + 1u) * nloc) {
            __builtin_amdgcn_fence(__ATOMIC_RELEASE, "agent");
            asm volatile("s_waitcnt vmcnt(0)" ::: "memory");
            const unsigned og = xb_add(&bar[XB_TOP], 1u);
            const unsigned tg = og / nx;
            if (og + 1u == (tg + 1u) * nx) xb_add(&bar[XB_TOPGEN], 1u);
            else XB_SPIN(xb_ld(&bar[XB_TOPGEN]) == tg, bar);
            __builtin_amdgcn_fence(__ATOMIC_ACQUIRE, "agent");
            xb_add(&bar[XB_XGEN(b.x)], 1u);
            asm volatile("s_waitcnt vmcnt(0)" ::: "memory");
        } else {
            XB_SPIN(xb_ld(&bar[XB_XGEN(b.x)]) == gen, bar);
            __builtin_amdgcn_fence(__ATOMIC_ACQUIRE, "agent");
            asm volatile("s_waitcnt vmcnt(0)" ::: "memory");
        }
    }
    __syncthreads();
}

typedef float f32x16 __attribute__((ext_vector_type(16)));
typedef unsigned u32x2 __attribute__((ext_vector_type(2)));
constexpr int NBATCH = 2, SEQL = 16384, DMODEL = 1024, NMETA = 16, TREAL = 16400, TALLOC = 16640, MALLOC = 2 * TALLOC;
constexpr int NWAVES = 8, MTILES = 32768;
constexpr int FFN_H = 2816;
constexpr int NIN = 3656, NIN_PAD = 3840, SIDE_W = 640, NSIDE = 584;
constexpr float RMS_EPS = 1e-6f;
constexpr float QSCALE = 0.125f * 1.4426950408889634f;
constexpr int MWORDS = 520;
constexpr int TOPK_NM = 240, TIE_CAP = 64;
constexpr float LAMBDA_INIT0 = 0.2f;

constexpr size_t MiB = 1u << 20;
constexpr size_t WS_CTL = 0, CTL_ZERO_BYTES = 1 * MiB;
constexpr size_t WS_WQKV = 2 * MiB, WS_WO1 = 8 * MiB, WS_WIN = 10 * MiB, WS_WO2 = 18 * MiB;
constexpr size_t WS_WUP = 20 * MiB  , WS_WDN = 42 * MiB  ;
constexpr size_t DO_TS = 0, DO_HL = 32 * MiB, DO_HF = 36 * MiB, DO_UM = 40 * MiB;
constexpr size_t WS_COS = 54 * MiB, WS_SIN = 57 * MiB;
constexpr size_t WS_H = 60 * MiB;
constexpr size_t WS_XN = 190 * MiB;
constexpr size_t WS_Q = 255 * MiB, WS_K = 320 * MiB, WS_V = 385 * MiB;
constexpr size_t WS_QI = 450 * MiB, WS_KI = 483 * MiB, WS_WI = 488 * MiB, WS_END = 512 * MiB;
constexpr size_t QKV_STRIDE = (WS_K - WS_Q) / 2;
static_assert(WS_V - WS_K == WS_K - WS_Q, "Q|K|V equally spaced");
constexpr int CW_BAR = 4096, CW_QUEUE = 32768;

constexpr int RING_BYTES = 131072, LDSCTL_OFF = RING_BYTES, MISC_OFF = LDSCTL_OFF + 320, ORD_OFF = LDSCTL_OFF + 1024, LDS_BYTES = 147456;

__constant__ float ROPE_INV[32] = {
    1.000000000e+00f, 7.498942614e-01f, 5.623413324e-01f, 4.216965139e-01f, 3.162277639e-01f, 2.371373773e-01f, 1.778279394e-01f, 1.333521307e-01f,
    1.000000015e-01f, 7.498941571e-02f, 5.623413250e-02f, 4.216965288e-02f, 3.162277490e-02f, 2.371373773e-02f, 1.778279431e-02f, 1.333521493e-02f,
    9.999999776e-03f, 7.498941850e-03f, 5.623413250e-03f, 4.216964822e-03f, 3.162277630e-03f, 2.371373586e-03f, 1.778279431e-03f, 1.333521446e-03f,
    1.000000047e-03f, 7.498942432e-04f, 5.623413017e-04f, 4.216965172e-04f, 3.162277571e-04f, 2.371373703e-04f, 1.778279402e-04f, 1.333521504e-04f};

__device__ __forceinline__ float wave_sum(float v) {
#pragma unroll
    for (int o = 1; o < 64; o <<= 1) v += __shfl_xor(v, o);
    return v;
}
__device__ __forceinline__ int crow32(int r, int hi) { return (r & 3) + 8 * (r >> 2) + 4 * hi; }
__device__ __forceinline__ unsigned long long pk4(f32x4 v) { return (unsigned long long)pk2(v.x, v.y) | ((unsigned long long)pk2(v.z, v.w) << 32); }
__device__ __forceinline__ int metarow(int r) { return (r >> 4) * TALLOC + (r & 15); }
__device__ __forceinline__ float bf2f(unsigned short b) { return __uint_as_float((unsigned)b << 16); }

__device__ __forceinline__ v4u widen16(unsigned long long w0, unsigned long long w1) {
    const auto lo = __builtin_amdgcn_permlane16_swap((unsigned)w0, (unsigned)w1, false, false); const auto hi = __builtin_amdgcn_permlane16_swap((unsigned)(w0 >> 32), (unsigned)(w1 >> 32), false, false);
    return v4u{lo[0], hi[0], lo[1], hi[1]};
}
__device__ __forceinline__ int wide_col(int fq, int nstride) { return (fq & 1) * nstride + 8 * (fq >> 1); }
template <class Q> struct EpiOf {
    static constexpr bool PERM = false, AFTER_DRAIN = false;
    Q q;
    __device__ __forceinline__ void operator()(const pg8::f32x4 (&acc)[2][2][4][2], const pg8::Unit& u, int wr, int wc, int fr, int fq) const {
        const int row0 = pg8::arow(u.pm) + wr * 64 + fr;
#pragma unroll
        for (int ai = 0; ai < 2; ++ai)
#pragma unroll
            for (int m = 0; m < 4; ++m)
#pragma unroll
                for (int bj = 0; bj < 2; ++bj) q.quad(row0 + ai * 128 + m * 16, u.pn, bj, wc, fq, acc[ai][bj][m][0], acc[ai][bj][m][1]);
    }
};
template <class Q> struct EpiOfW {
    static constexpr bool PERM = false, AFTER_DRAIN = false;
    Q q;
    __device__ __forceinline__ void operator()(const pg8::f32x4 (&acc)[2][2][4][2], const pg8::Unit& u, int wr, int wc, int fr, int fq) const {
        const int row0 = pg8::arow(u.pm) + wr * 64 + fr;
#pragma unroll
        for (int ai = 0; ai < 2; ++ai)
#pragma unroll
            for (int m = 0; m < 4; ++m)
#pragma unroll
                for (int bj = 0; bj < 2; ++bj) q.quadw(row0 + ai * 128 + m * 16, u.pn, bj, wc, fq, acc[ai][bj][m][0], acc[ai][bj][m][1]);
    }
};
struct QuadRope {
    bf16* Q; float* side; const float *cosT, *sinT;
    __device__ __forceinline__ void quad(int row, int pn, int bj, int wc, int fq, f32x4 v0, f32x4 v1) const {
        if (pn < 12) {
            const int t = pn >> 2, g = bj * 4 + wc, hh = (pn & 3) * 4 + (g >> 1), db = 16 * (g & 1) + 4 * fq;
            f32x4 y0 = v0, y1 = v1;
            if (t < 2) {
                const int pos = row >= TALLOC ? row - TALLOC : row;
                const f32x4 c = *(const GAS f32x4*)(cosT + pos * 32 + db), s = *(const GAS f32x4*)(sinT + pos * 32 + db);
                y0 = v0 * c - v1 * s; y1 = v1 * c + v0 * s;
                if (t == 0) { y0 = y0 * QSCALE; y1 = y1 * QSCALE; }
            }
            bf16* dst = Q + (size_t)t * QKV_STRIDE + (size_t)row * 1024 + hh * 64 + db;
            *(GAS unsigned long long*)dst = pk4(y0); *(GAS unsigned long long*)(dst + 32) = pk4(y1);
        } else {
            const int col = 256 * pn + 128 * bj + 32 * wc + 4 * fq - 3072;
            if (col < NSIDE) *(GAS f32x4*)(side + (size_t)row * SIDE_W + col) = v0;
            if (col + 16 < NSIDE) *(GAS f32x4*)(side + (size_t)row * SIDE_W + col + 16) = v1;
        }
    }
    __device__ __forceinline__ void quadw(int row, int pn, int bj, int wc, int fq, f32x4 v0, f32x4 v1) const {
        if (pn < 12) {
            const int t = pn >> 2, g = bj * 4 + wc, hh = (pn & 3) * 4 + (g >> 1), db = 16 * (g & 1) + 4 * fq;
            f32x4 y0 = v0, y1 = v1;
            if (t < 2) {
                const int pos = row >= TALLOC ? row - TALLOC : row;
                const f32x4 c = *(const GAS f32x4*)(cosT + pos * 32 + db), s = *(const GAS f32x4*)(sinT + pos * 32 + db);
                y0 = v0 * c - v1 * s; y1 = v1 * c + v0 * s;
                if (t == 0) { y0 = y0 * QSCALE; y1 = y1 * QSCALE; }
            }
            bf16* dst = Q + (size_t)t * QKV_STRIDE + (size_t)row * 1024 + hh * 64 + 16 * (g & 1) + wide_col(fq, 32);
            *(GAS v4u*)dst = widen16(pk4(y0), pk4(y1));
        } else {
            const int col = 256 * pn + 128 * bj + 32 * wc + 4 * fq - 3072;
            if (col < NSIDE) *(GAS f32x4*)(side + (size_t)row * SIDE_W + col) = v0;
            if (col + 16 < NSIDE) *(GAS f32x4*)(side + (size_t)row * SIDE_W + col + 16) = v1;
        }
    }
};
struct QuadResid {
    float* H; float sgn;
    __device__ __forceinline__ void quad(int row, int pn, int bj, int wc, int fq, f32x4 v0, f32x4 v1) const {
        float* p = H + (size_t)row * 1024 + 256 * pn + 128 * bj + 32 * wc + 4 * fq;
        const f32x4 a = *(const GAS f32x4*)p, b = *(const GAS f32x4*)(p + 16);
        *(GAS f32x4*)p = a + sgn * v0; *(GAS f32x4*)(p + 16) = b + sgn * v1;
    }
};
struct QuadPlain {
    bf16* U; int ldu;
    __device__ __forceinline__ void quad(int row, int pn, int bj, int wc, int fq, f32x4 v0, f32x4 v1) const {
        bf16* p = U + (size_t)row * ldu + 256 * pn + 128 * bj + 32 * wc + 4 * fq;
        *(GAS unsigned long long*)p = pk4(v0); *(GAS unsigned long long*)(p + 16) = pk4(v1);
    }
};


__device__ __forceinline__ float silu_mul(float g, float v) { return g * v * __builtin_amdgcn_rcpf(1.f + __builtin_amdgcn_exp2f(g * -1.4426950408889634f)); }
struct EpiFfn {
    static constexpr bool PERM = false, AFTER_DRAIN = false;
    bf16* ts;
    bf16 *HL, *HF;
    bf16* ACT;
    const float *cw, *cb;
    __device__ __forceinline__ void operator()(const pg8::f32x4 (&acc)[2][2][4][2], const pg8::Unit& u, int wr, int wc, int fr_in, int fq_in) const {
        int fr = fr_in, fq = fq_in; asm volatile("" : "+v"(fr), "+v"(fq));
        GAS bf16* tsg = (GAS bf16*)ts;
#pragma unroll
        for (int ai = 0; ai < 2; ++ai)
#pragma unroll
            for (int m = 0; m < 4; ++m) { const int R = 128 * ai + 64 * wr + 16 * m + fr;
#pragma unroll
                for (int bj = 0; bj < 2; ++bj) { const int p = 128 * bj + 32 * wc + wide_col(fq, 16); const v4u w = widen16(pk4(acc[ai][bj][m][0]), pk4(acc[ai][bj][m][1]));
                        *(GAS v4u*)(tsg + R * 256 + p) = w;
                        if (ai == 0 && m == 0) { if (wr == 0 && fr < 2) *(GAS v4u*)((GAS bf16*)HF + ((size_t)(u.pm * 2 + fr)) * (2 * FFN_H) + 256 * u.pn + p) = w; }
                        if (ai == 1 && m == 3) { if (wr == 1 && fr >= 14) *(GAS v4u*)((GAS bf16*)HL + ((size_t)(u.pm * 2 + fr - 14)) * (2 * FFN_H) + 256 * u.pn + p) = w; } } }
        asm volatile("s_waitcnt vmcnt(0)\n\ts_barrier" ::: "memory");
        const int t = (wr * 4 + wc) * 64 + fq * 16 + fr, cgp = t & 15, rb = t >> 4, h8 = 8 * cgp, hcol = 128 * u.pn + h8, row0 = pg8::arow(u.pm);
        float wg[3][8], wv[3][8], bg[8], bv[8];
#pragma unroll
        for (int j = 0; j < 3; ++j) { const GAS f32x4* a = (const GAS f32x4*)(cw + (size_t)j * 2 * FFN_H + hcol); const GAS f32x4* b = (const GAS f32x4*)(cw + (size_t)j * 2 * FFN_H + FFN_H + hcol);
            const f32x4 a0 = a[0], a1 = a[1], b0 = b[0], b1 = b[1];
            wg[j][0] = a0.x; wg[j][1] = a0.y; wg[j][2] = a0.z; wg[j][3] = a0.w; wg[j][4] = a1.x; wg[j][5] = a1.y; wg[j][6] = a1.z; wg[j][7] = a1.w;
            wv[j][0] = b0.x; wv[j][1] = b0.y; wv[j][2] = b0.z; wv[j][3] = b0.w; wv[j][4] = b1.x; wv[j][5] = b1.y; wv[j][6] = b1.z; wv[j][7] = b1.w; }
        { const GAS f32x4* a = (const GAS f32x4*)(cb + hcol); const GAS f32x4* b = (const GAS f32x4*)(cb + FFN_H + hcol); const f32x4 a0 = a[0], a1 = a[1], b0 = b[0], b1 = b[1];
          bg[0] = a0.x; bg[1] = a0.y; bg[2] = a0.z; bg[3] = a0.w; bg[4] = a1.x; bg[5] = a1.y; bg[6] = a1.z; bg[7] = a1.w; bv[0] = b0.x; bv[1] = b0.y; bv[2] = b0.z; bv[3] = b0.w; bv[4] = b1.x; bv[5] = b1.y; bv[6] = b1.z; bv[7] = b1.w; }
        const GAS v4u* tg = (const GAS v4u*)(tsg + h8); const GAS v4u* tv = (const GAS v4u*)(tsg + 128 + h8);
        v4u g0 = v4u{0, 0, 0, 0}, g1 = g0, v0 = g0, v1 = g0;
        if (rb > 0) { g0 = __builtin_nontemporal_load(tg + (8 * rb - 2) * 32); g1 = __builtin_nontemporal_load(tg + (8 * rb - 1) * 32); v0 = __builtin_nontemporal_load(tv + (8 * rb - 2) * 32); v1 = __builtin_nontemporal_load(tv + (8 * rb - 1) * 32); }
#pragma unroll
        for (int i = 0; i < 8; ++i) { const int R = 8 * rb + i;
            const v4u g2 = __builtin_nontemporal_load(tg + R * 32), v2 = __builtin_nontemporal_load(tv + R * 32);
            const unsigned gw[3][4] = {{g0.x, g0.y, g0.z, g0.w}, {g1.x, g1.y, g1.z, g1.w}, {g2.x, g2.y, g2.z, g2.w}}, vw[3][4] = {{v0.x, v0.y, v0.z, v0.w}, {v1.x, v1.y, v1.z, v1.w}, {v2.x, v2.y, v2.z, v2.w}};
            unsigned w[4];
#pragma unroll
            for (int e = 0; e < 4; ++e) { float cg0 = bg[2 * e], cg1 = bg[2 * e + 1], cv0 = bv[2 * e], cv1 = bv[2 * e + 1];
#pragma unroll
                for (int j = 0; j < 3; ++j) { cg0 += wg[j][2 * e] * __uint_as_float(gw[j][e] << 16); cg1 += wg[j][2 * e + 1] * __uint_as_float(gw[j][e] & 0xffff0000u);
                    cv0 += wv[j][2 * e] * __uint_as_float(vw[j][e] << 16); cv1 += wv[j][2 * e + 1] * __uint_as_float(vw[j][e] & 0xffff0000u); }
                w[e] = pk2(silu_mul(cg0, cv0), silu_mul(cg1, cv1)); }
            if (R >= 2) *(GAS v4u*)((GAS bf16*)ACT + (size_t)(row0 + R) * FFN_H + hcol) = v4u{w[0], w[1], w[2], w[3]};
            g0 = g1; g1 = g2; v0 = v1; v1 = v2; }
    }
};
struct QuadMetaU {
    bf16* UM;
    __device__ __forceinline__ void quad(int row, int pn, int bj, int wc, int fq, f32x4 v0, f32x4 v1) const {
        const int r = (row >= TALLOC ? 16 + row - TALLOC : row);
        GAS bf16* p = (GAS bf16*)UM + (size_t)r * (2 * FFN_H) + 256 * pn + 128 * bj + 32 * wc + 4 * fq;
        *(GAS unsigned long long*)p = pk4(v0); *(GAS unsigned long long*)(p + 16) = pk4(v1);
    }
};
template <class Epi> __device__ __forceinline__ void run_gemm_epi(LAS unsigned char* lds, const bf16* A, const bf16* Bt, int N, int K, const Epi& E, int G, const int wv_) {
    pg8::Gemm g{A, Bt, MTILES, N, K}; pg8::StaticOrder S; S.init(MTILES, N, G, (int)blockIdx.x);
    pg8::gemm_phase<Epi, pg8::StaticOrder, true, true>(lds, g, S, E, wv_);
}

template <class Q> __device__ __forceinline__ void run_gemm(LAS unsigned char* lds, const bf16* A, const bf16* Bt, int N, int K, const Q& q, int G, const int wv_) {
    pg8::Gemm g{A, Bt, MTILES, N, K}; pg8::StaticOrder S; S.init(MTILES, N, G, (int)blockIdx.x);
    EpiOf<Q> E{q};
    pg8::gemm_phase<EpiOf<Q>, pg8::StaticOrder, true, true>(lds, g, S, E, wv_);
}
template <class Q> __device__ __forceinline__ void meta_gemm(LAS unsigned char* lds, const bf16* A, const bf16* Bt, int N, int K, const Q& q, int vcu, int G, const int wv_) {
    int tid_ = wv_ * 64 + lane_id(); asm volatile("" : "+v"(tid_));
    const int tid = tid_, lane = tid & 63, wid = __builtin_amdgcn_readfirstlane(tid >> 6), r32 = lane & 31, hi = lane >> 5;
    LAS float* tile = (LAS float*)lds;
    for (int pn = vcu; pn < N / 256; pn += G) {
        const bf16* ap = A + (size_t)metarow(r32) * K + 8 * hi;
        const bf16* bp = Bt + (size_t)(256 * pn + 32 * wid + r32) * K + 8 * hi;
        float zf_ = 0.f; asm volatile("" : "+v"(zf_)); f32x16 acc = {zf_, zf_, zf_, zf_, zf_, zf_, zf_, zf_, zf_, zf_, zf_, zf_, zf_, zf_, zf_, zf_};
#pragma unroll 8
        for (int kk = 0; kk < K / 16; ++kk) {
            const bf16x8 a = *(const GAS bf16x8*)(ap + 16 * kk), b = *(const GAS bf16x8*)(bp + 16 * kk);
            acc = __builtin_amdgcn_mfma_f32_32x32x16_bf16(a, b, acc, 0, 0, 0);
        }
#pragma unroll
        for (int r = 0; r < 16; ++r) tile[crow32(r, hi) * 260 + 32 * wid + r32] = acc[r];
        __syncthreads();
#pragma unroll
        for (int i = 0; i < 2; ++i) {
            const int v = tid * 2 + i, r = v >> 5, g = (v >> 2) & 7, fq = v & 3;
            const f32x4 x0 = *(const LAS f32x4*)(tile + r * 260 + 32 * g + 4 * fq), x1 = *(const LAS f32x4*)(tile + r * 260 + 32 * g + 16 + 4 * fq);
            q.quad(metarow(r), pn, g >> 2, g & 3, fq, x0, x1);
        }
        __syncthreads();
    }
}

struct Mat { const float* W; int ldw, koff, Kp, Np, map; bf16* WT; };
__device__ __forceinline__ int rope_sigma(int n) { const int pn = n >> 8, p = n & 255, g = p >> 5, nn = (p >> 4) & 1, r = p & 15; return 256 * pn + 64 * (g >> 1) + 32 * nn + 16 * (g & 1) + r; }
__device__ __forceinline__ int src_col(int map, int n) {
    if (map == 0) return n;
    if (map == 1) return rope_sigma(n);
    if (map == 2) return n < 3072 ? rope_sigma(n) : (n < NIN ? n : -1);
    { const int pn = n >> 8, p = n & 255; return p < 128 ? 128 * pn + p : FFN_H + 128 * pn + (p - 128); }
}
__device__ __forceinline__ void wt_item(const Mat& m, int item, LAS float* scr, int lane) {
    const int nblk = m.Np / 32, kb = item / nblk, nb = item % nblk, k0 = 64 * kb, n0 = 32 * nb;
    const int src = src_col(m.map, n0 + (lane & 31));
#pragma unroll 8
    for (int i = 0; i < 32; ++i) { const int kk = 2 * i + (lane >> 5); scr[kk * 33 + (lane & 31)] = src >= 0 ? m.W[(size_t)(m.koff + k0 + kk) * m.ldw + src] : 0.f; }
    LDS_WAIT(); asm volatile("" ::: "memory");
    const int c = lane & 7;
#pragma unroll
    for (int j = 0; j < 4; ++j) { const int n = (lane >> 3) + 8 * j; const LAS float* s = scr + (8 * c) * 33 + n;
        v4u o; o.x = pk2(s[0 * 33], s[1 * 33]); o.y = pk2(s[2 * 33], s[3 * 33]); o.z = pk2(s[4 * 33], s[5 * 33]); o.w = pk2(s[6 * 33], s[7 * 33]);
        *(v4u*)(m.WT + (size_t)(n0 + n) * m.Kp + k0 + 8 * c) = o; }
    LDS_WAIT(); asm volatile("" ::: "memory");
}
__device__ __forceinline__ void rms_row_bf16(const float* xrow, const float* g, bf16* orow, float* copy, int lane) {
    const GAS f32x4* xr = (const GAS f32x4*)xrow + lane; f32x4 v[4]; float s = 0.f;
#pragma unroll
    for (int j = 0; j < 4; ++j) { v[j] = xr[64 * j]; s += (v[j].x * v[j].x + v[j].y * v[j].y) + (v[j].z * v[j].z + v[j].w * v[j].w); }
    const float r = 1.0f / sqrtf(wave_sum(s) * (1.f / 1024.f) + RMS_EPS);
    GAS unsigned long long* o8 = (GAS unsigned long long*)orow + lane; const GAS f32x4* gr = (const GAS f32x4*)g + lane;
#pragma unroll
    for (int j = 0; j < 4; ++j) { const f32x4 gg = gr[64 * j]; o8[64 * j] = pk4(v[j] * r * gg); if (copy) ((GAS f32x4*)copy + lane)[64 * j] = v[j]; }
}


constexpr int TK_HS = 513, TK_ST_OFF = 66560, TK_TIE_OFF = TK_ST_OFF + 2048, TK_Q_OFF = 90112, TK_CAND_CAP = 1024;
__device__ __forceinline__ void tk_sweep(LAS unsigned char* lds, const bf16* KI, unsigned long long* cand, const float (&wq)[8], int wave, int lane_in, int nbv, int smpR, unsigned* smp, int u,
                                         int rowbase, int pos_q, unsigned klo_q, unsigned khi_q, bool done_q, unsigned shift_q, bool do_hist, bool do_collect, bool track) {
    LAS unsigned* hist = (LAS unsigned*)lds; LAS unsigned* st = (LAS unsigned*)(lds + TK_ST_OFF); LAS unsigned* st_kmax = st + 192; LAS unsigned* cand_cnt = st + 256;
    LAS unsigned char* qlds = lds + TK_Q_OFF;
    int lane = lane_in; asm volatile("" : "+v"(lane));
    const int qi = lane & 31, hi = lane >> 5;
    int sb = wave; if (2 * sb >= nbv) return;
    const GAS bf16* kbase = (const GAS bf16*)KI + (size_t)(rowbase + (smpR ? 32 : qi)) * 64 + hi * 8;
    LAS unsigned char* qlane = qlds + lane * 16; asm volatile("" : "+v"(qlane));
    bf16x8 kc0[4], kc1[4], kn0[4], kn1[4]; unsigned lmax = 0u;
    unsigned klo_c = klo_q == 0x7fffffffu ? 0x80000000u : klo_q, khi_c = khi_q == 0x7fffffffu ? 0x7ffffffeu : khi_q;
    const float f_lo = klo_c <= 0x007fffffu ? -__builtin_inff() : __uint_as_float((klo_c & 0x80000000u) ? (klo_c ^ 0x80000000u) : ~klo_c);
    const float f_hi = khi_c >= 0xff800000u ? __builtin_inff() : (khi_c < 0x007fffffu ? -__builtin_inff() : __uint_as_float((khi_c & 0x80000000u) ? (khi_c ^ 0x80000000u) : ~khi_c));
#define TK_KLD(dst, vv) do { int v_ = (vv); v_ = v_ < nbv ? v_ : nbv - 1; _Pragma("unroll") for (int kk = 0; kk < 4; ++kk) dst[kk] = *(const GAS bf16x8*)(kbase + (size_t)(smpR ? (((v_ * 32 + qi) * smpR) >> 10) * 64 : v_ * 2048) + kk * 16); } while (0)
    TK_KLD(kc0, 2 * sb); TK_KLD(kc1, 2 * sb + 1);
    for (; 2 * sb < nbv; sb += 8) {
        {
            const int v = 2 * sb;
            { const int nv = 2 * (sb + 8); TK_KLD(kn0, nv); TK_KLD(kn1, nv + 1); }
            {
                float sc0[16], sc1[16]; bf16x8 qa[4]; f32x16 accA, accB;
#define TK_QLD(dst, h) _Pragma("unroll") for (int kk = 0; kk < 4; ++kk) dst[kk] = *(const LAS bf16x8*)(qlane + ((h) * 4 + kk) * 1024)
#define TK_MM(acc, kc, q) do { acc = __builtin_amdgcn_mfma_f32_32x32x16_bf16(kc[0], q[0], zero16, 0, 0, 0); _Pragma("unroll") for (int kk = 1; kk < 4; ++kk) acc = __builtin_amdgcn_mfma_f32_32x32x16_bf16(kc[kk], q[kk], acc, 0, 0, 0); } while (0)
#define TK_RELU(x) __int_as_float(max(__float_as_int(x), 0))
#define TK_ACC0(sc, acc, h) _Pragma("unroll") for (int r = 0; r < 16; ++r) asm("v_mul_f32_e32 %0, %1, %2" : "=v"(sc[r]) : "v"(wq[h]), "v"(TK_RELU(acc[r])))
#define TK_ACC(sc, acc, h) _Pragma("unroll") for (int r = 0; r < 16; ++r) asm("v_fmac_f32_e32 %0, %1, %2" : "+v"(sc[r]) : "v"(wq[h]), "v"(TK_RELU(acc[r])))
                float zf_ = 0.f; asm volatile("" : "+v"(zf_)); const f32x16 zero16 = {zf_, zf_, zf_, zf_, zf_, zf_, zf_, zf_, zf_, zf_, zf_, zf_, zf_, zf_, zf_, zf_};
                DILS_B(8);
#define TK_MMA(acc, kc, q) _Pragma("unroll") for (int kk = 0; kk < 4; ++kk) acc = __builtin_amdgcn_mfma_f32_32x32x16_bf16(kc[kk], q[kk], acc, 0, 0, 0)
#define TK_ABS(sc, acc, h) _Pragma("unroll") for (int r = 0; r < 16; ++r) { sc[r] = __builtin_fmaf(__builtin_fabsf(acc[r]), wq[h], sc[r]); asm("" : "+v"(sc[r])); }
                TK_QLD(qa, 8); __builtin_amdgcn_sched_barrier(0);
                f32x16 linA, linB;
                TK_MM(linA, kc0, qa); TK_MM(linB, kc1, qa); TK_QLD(qa, 9); __builtin_amdgcn_sched_barrier(0);
                TK_MMA(linA, kc0, qa); TK_MMA(linB, kc1, qa); TK_QLD(qa, 0); __builtin_amdgcn_sched_barrier(0);
#pragma unroll
                for (int r = 0; r < 16; ++r) { sc0[r] = linA[r]; sc1[r] = linB[r]; }
#define TK_HEAD(h) TK_MM(accA, kc0, qa); TK_MM(accB, kc1, qa); if ((h) < 7) { TK_QLD(qa, ((h) < 7 ? (h) + 1 : 7)); } TK_ABS(sc0, accA, h); TK_ABS(sc1, accB, h); __builtin_amdgcn_sched_barrier(0)
                TK_HEAD(0); TK_HEAD(1); TK_HEAD(2); TK_HEAD(3); TK_HEAD(4); TK_HEAD(5); TK_HEAD(6); TK_HEAD(7);
#undef TK_MMA
#undef TK_ABS
                DILS_E(8);
#undef TK_HEAD
#undef TK_QLD
#undef TK_MM
#undef TK_RELU
#undef TK_ACC0
#undef TK_ACC
#define TK_POST(sc, vv) do { const int v_ = (vv); if (v_ < nbv) { const int kb = v_; const bool edge = !track && ((kb == 0) || (kb >= u));     \
                    unsigned inr = 0u;                                                        \
                    if (!edge && !track) { _Pragma("unroll") for (int r = 15; r >= 0; --r) { float md_; asm("v_med3_f32 %1, %2, %3, %4\n\tv_cmp_eq_f32_e32 vcc, %1, %2\n\tv_addc_co_u32_e32 %0, vcc, %0, %0, vcc" : "+v"(inr), "=&v"(md_) : "v"(sc[r]), "v"(f_lo), "v"(f_hi) : "vcc"); } }     \
                    else { _Pragma("unroll") for (int r = 0; r < 16; ++r) { const int kpos = 32 * kb + crow32(r, hi); const bool valid = !edge || (kpos >= NMETA && kpos <= pos_q); \
                            inr |= (valid && sc[r] >= f_lo && sc[r] <= f_hi) ? (1u << r) : 0u; \
                            if (track) { const unsigned fb = __float_as_uint(sc[r] + 0.0f), key = fb ^ ((unsigned)((int)fb >> 31) | 0x80000000u); lmax = key > lmax ? key : lmax;     \
                                *(GAS unsigned*)(smp + qi * 1024 + v_ * 32 + crow32(r, hi)) = key; \
                                if (!done_q) { unsigned bin = (key - klo_q) >> shift_q; bin = bin > 1023u ? 1023u : bin; __hip_atomic_fetch_add(hist + qi * TK_HS + (bin >> 1), 1u << ((bin & 1u) * 16u), __ATOMIC_RELAXED, __HIP_MEMORY_SCOPE_WORKGROUP); } } } \
                      if (track) inr = 0u; } \
                    if (done_q) inr = 0u; \
                    unsigned ix = 0u;                                                         \
                    if (do_collect && inr) ix = __hip_atomic_fetch_add(cand_cnt + qi, (unsigned)__builtin_popcount(inr), __ATOMIC_RELAXED, __HIP_MEMORY_SCOPE_WORKGROUP); \
                    while (__any(inr != 0u)) {                                                \
                        const bool has = inr != 0u; const unsigned r = has ? (unsigned)__builtin_ctz(inr) : 0u; inr &= inr - 1u; \
                        const bool b0_ = (r & 1u) != 0u, b1_ = (r & 2u) != 0u, b2_ = (r & 4u) != 0u, b3_ = (r & 8u) != 0u;     \
                        const float t0_ = b0_ ? sc[1] : sc[0], t1_ = b0_ ? sc[3] : sc[2], t2_ = b0_ ? sc[5] : sc[4], t3_ = b0_ ? sc[7] : sc[6], t4_ = b0_ ? sc[9] : sc[8], t5_ = b0_ ? sc[11] : sc[10], t6_ = b0_ ? sc[13] : sc[12], t7_ = b0_ ? sc[15] : sc[14]; \
                        const float u0_ = b1_ ? t1_ : t0_, u1_ = b1_ ? t3_ : t2_, u2_ = b1_ ? t5_ : t4_, u3_ = b1_ ? t7_ : t6_; \
                        const float sv = b3_ ? (b2_ ? u3_ : u2_) : (b2_ ? u1_ : u0_); \
                        if (has) { const unsigned fb = __float_as_uint(sv + 0.0f), key = fb ^ ((unsigned)((int)fb >> 31) | 0x80000000u); \
                            if (do_hist) { unsigned bin = (key - klo_q) >> shift_q; bin = bin > 1023u ? 1023u : bin; \
                                __hip_atomic_fetch_add(hist + qi * TK_HS + (bin >> 1), 1u << ((bin & 1u) * 16u), __ATOMIC_RELAXED, __HIP_MEMORY_SCOPE_WORKGROUP); } \
                            if (do_collect) { if (ix < (unsigned)TK_CAND_CAP) *(GAS u32x2*)(cand + (size_t)qi * TK_CAND_CAP + ix) = u32x2{key, (unsigned)(32 * kb + 4 * hi) + (r & 3u) + 8u * (r >> 2)}; ++ix; } } } } } while (0)
                DILS_B(9);
                TK_POST(sc0, v); TK_POST(sc1, v + 1);
                DILS_E(9);
#undef TK_POST
            }
#pragma unroll
            for (int kk = 0; kk < 4; ++kk) { kc0[kk] = kn0[kk]; kc1[kk] = kn1[kk]; }
        }
    }
#undef TK_KLD
    if (track) __hip_atomic_fetch_max(st_kmax + qi, lmax, __ATOMIC_RELAXED, __HIP_MEMORY_SCOPE_WORKGROUP);
}

struct Args { const float* in[20]; float* out; unsigned char* ws; int ph_lo, ph_hi; };
enum { IN_X = 0, IN_META, IN_DA_NORM, IN_DA_WQKV, IN_LQ1, IN_LK1, IN_LQ2, IN_LK2, IN_SUBLN, IN_DA_WO, IN_DSA_NORM, IN_DSA_WIN, IN_IDX_KNORM, IN_DSA_WO, IN_FFN_NORM, IN_FFN_WUP, IN_CONV_W, IN_CONV_B, IN_FFN_WDN, IN_FINAL_NORM };
constexpr int N_PHASES = 25;

__global__ void __launch_bounds__(NWAVES * 64, 2) fwd(Args args) {
    extern __shared__ __attribute__((aligned(16))) unsigned char lds_raw[];
    LAS unsigned char* lds = (LAS unsigned char*)lds_raw;
    volatile LAS unsigned* MISC = (volatile LAS unsigned*)(lds + MISC_OFF);
    const int G = gridDim.x, bx = blockIdx.x, vcu = (G % 8 == 0) ? (bx % 8) * (G / 8) + bx / 8 : bx;
    const int NGW = G * NWAVES, NGT = NGW * 64;
#define PTRS() unsigned char* ws = args.ws; float* outp = args.out; asm volatile("" : "+s"(ws), "+s"(outp)); \
    int tid_ = wave_s * 64 + lane_id(); asm volatile("" : "+v"(tid_)); const int tid = tid_, lane = tid & 63, wave = wave_s; \
    const int gw = vcu * NWAVES + wave, gtid = gw * 64 + lane; (void)gw; (void)gtid; (void)lane; \
    bf16* const WQKV_T = (bf16*)(ws + WS_WQKV); bf16* const WO1_T = (bf16*)(ws + WS_WO1); bf16* const WIN_T = (bf16*)(ws + WS_WIN); bf16* const WO2_T = (bf16*)(ws + WS_WO2); \
    float* const COS = (float*)(ws + WS_COS); float* const SIN = (float*)(ws + WS_SIN); float* const H = (float*)(ws + WS_H); \
    bf16* const XN = (bf16*)(ws + WS_XN); bf16* const QB = (bf16*)(ws + WS_Q); bf16* const KB = (bf16*)(ws + WS_K); bf16* const VB = (bf16*)(ws + WS_V); bf16* const UB = (bf16*)(ws + WS_Q); \
    bf16* const QI = (bf16*)(ws + WS_QI); bf16* const KI = (bf16*)(ws + WS_KI); float* const WI = (float*)(ws + WS_WI); \
    bf16* const O0 = XN; bf16* const O1 = (bf16*)outp; bf16* const ACT = (bf16*)outp; float* const SIDE = outp; unsigned* const MASK = (unsigned*)outp; \
    (void)WQKV_T; (void)WO1_T; (void)WIN_T; (void)WO2_T; (void)COS; (void)SIN; (void)H; (void)XN; (void)QB; (void)KB; (void)VB; (void)UB; (void)QI; (void)KI; (void)WI; (void)O0; (void)O1; (void)ACT; (void)SIDE; (void)MASK
    gu32* ctl = (gu32*)(args.ws + WS_CTL);
    const int wave_s = __builtin_amdgcn_readfirstlane((int)threadIdx.x >> 6);
    for (int u = wave_s * 64 + lane_id(); u < (LDS_BYTES - LDSCTL_OFF) / 4; u += NWAVES * 64) ((LAS unsigned*)(lds + LDSCTL_OFF))[u] = 0u;
    __syncthreads();
    const int lo = args.ph_lo, hi_ph = args.ph_hi;
    const bool use_bar = (hi_ph - lo) > 1;
    XcdBarrier bar; bar.bar = (unsigned*)(ctl + CW_BAR); bar.x = 0; bar.st = nullptr;
    if (use_bar) bar = xcd_barrier_post((unsigned*)(ctl + CW_BAR), MISC + 8, wave_s);
#ifndef REPMASK
#define REPMASK 0u
#endif
#ifndef REPCNT
#define REPCNT 1
#endif
#ifdef DILMASK
#define DIL_B(k) const bool dil_on_ = ((k) - P == (DILMASK) % 100) && (layer == (DILMASK) / 100); const unsigned long long dil_t0_ = dil_on_ ? __builtin_amdgcn_s_memrealtime() : 0ull
#define DIL_E(k) do { if (dil_on_) { const unsigned long long t1_ = __builtin_amdgcn_s_memrealtime(), d_ = t1_ - dil_t0_; while (__builtin_amdgcn_s_memrealtime() - t1_ < d_) __builtin_amdgcn_s_sleep(4); } } while (0)
#else
#define DIL_B(k)
#define DIL_E(k) do { } while (0)
#endif
#define REP_BEGIN(k) for (int rep_ = 0; rep_ <= REPCNT * (int)(((unsigned)(REPMASK) >> (k)) & 1u); ++rep_) { DIL_B(k);
#define REP_END(k) DIL_E(k); if (rep_ < REPCNT * (int)(((unsigned)(REPMASK) >> (k)) & 1u)) xcd_barrier(bar, wave_s); }
#ifndef EN_MASK
#define EN_MASK 0x1fff
#endif
#define IN(k) (lo <= (k) && (k) < hi_ph)
#define INA(a) ((((EN_MASK) >> (a)) & 1) && IN(P + (a)))
#ifdef DIAG_A
#define STAMP(k) do { if (bx == 0 && wave_s == 0 && lane_id() == 0) __hip_atomic_store((unsigned long long*)(args.ws + 65536) + (k), (unsigned long long)__builtin_amdgcn_s_memrealtime(), __ATOMIC_RELAXED, __HIP_MEMORY_SCOPE_AGENT); } while (0)
#else
#define STAMP(k) do { } while (0)
#endif
#define SEAM(k) do { if (IN(k) && IN((k) + 1)) { xcd_barrier(bar, wave_s); STAMP((k) + 1); } } while (0)

#ifndef FULLREP
#define FULLREP 0
#endif
    for (int full_ = 0; full_ <= FULLREP; ++full_) {
    STAMP(0);
    if (((EN_MASK >> 12) & 1) && IN(0)) { PTRS(); constexpr int P = -1000, layer = -1; REP_BEGIN(0)
        LAS float* scr = (LAS float*)(lds + wave * 16384);
        constexpr int I0 = 16 * 96, I1 = 16 * 32, I2 = 16 * 120, I3 = 16 * 32, IUP = 16 * 176, IDN = 44 * 32;
        constexpr int NITEMS = I0 + I1 + I2 + I3 + 2 * (IUP + IDN);
        for (int it = gw; it < NITEMS; it += NGW) {
            int r = it; Mat m;
            if (r < I0) m = Mat{args.in[IN_DA_WQKV], 3072, 0, 1024, 3072, 1, WQKV_T};
            else if ((r -= I0) < I1) m = Mat{args.in[IN_DA_WO], 1024, 0, 1024, 1024, 0, WO1_T};
            else if ((r -= I1) < I2) m = Mat{args.in[IN_DSA_WIN], NIN, 0, 1024, NIN_PAD, 2, WIN_T};
            else if ((r -= I2) < I3) m = Mat{args.in[IN_DSA_WO], 1024, 0, 1024, 1024, 0, WO2_T};
            else { r -= I3; const int per = IUP + IDN, l = r / per; r -= l * per;
                const float* wup = args.in[IN_FFN_WUP] + (size_t)l * 1024 * 2 * FFN_H; const float* wdn = args.in[IN_FFN_WDN] + (size_t)l * FFN_H * 1024;
                if (r < IUP) m = Mat{wup, 2 * FFN_H, 0, 1024, 2 * FFN_H, 3, (bf16*)(ws + WS_WUP + l * 11 * MiB)};
                else { r -= IUP; m = Mat{wdn, 1024, 0, FFN_H, 1024, 0, (bf16*)(ws + WS_WDN + l * (11 * MiB / 2))}; } }
            wt_item(m, r, scr, lane);
        }
        for (int i = gtid; i < TALLOC * 32; i += NGT) { const float ang = (float)(i >> 5) * ROPE_INV[i & 31]; COS[i] = (float)cos((double)ang); SIN[i] = (float)sin((double)ang); }
        for (int r = gw; r < NBATCH * TREAL; r += NGW) { const int b = r / TREAL, pos = r - b * TREAL, row = b * TALLOC + pos;
            const float* src = pos < NMETA ? args.in[IN_META] + (size_t)pos * 1024 : args.in[IN_X] + ((size_t)b * SEQL + pos - NMETA) * 1024;
            rms_row_bf16(src, args.in[IN_DA_NORM], XN + (size_t)row * 1024, H + (size_t)row * 1024, lane); }
        for (int r = gw; r < 2 * NBATCH * (TALLOC - TREAL); r += NGW) { const int which = r / (NBATCH * (TALLOC - TREAL)), rr = r % (NBATCH * (TALLOC - TREAL)), b = rr / (TALLOC - TREAL), pos = TREAL + rr % (TALLOC - TREAL);
            v4u* p = (v4u*)(KB + (size_t)which * QKV_STRIDE + (size_t)(b * TALLOC + pos) * 1024); unsigned z = 0u; asm volatile("" : "+v"(z)); p[lane] = v4u{z, z, z, z}; p[lane + 64] = v4u{z, z, z, z}; }
    REP_END(0) }
    SEAM(0);

    for (int layer = 0; layer < 2; ++layer) {
        const int P = 1 + 12 * layer;
#ifdef IDLE_US
        if (layer == IDLE_AT) { const unsigned long long t0_ = __builtin_amdgcn_s_memrealtime(); while (__builtin_amdgcn_s_memrealtime() - t0_ < 100ull * IDLE_US) __builtin_amdgcn_s_sleep(8); }
#endif
        if (INA(0)) { PTRS(); REP_BEGIN(P + 0)
            const QuadRope q{QB, SIDE, COS, SIN};
            const bf16* Wt = layer == 0 ? WQKV_T : WIN_T; const int N = layer == 0 ? 3072 : NIN_PAD;
            { const EpiOfW<QuadRope> E{q}; run_gemm_epi(lds, XN, Wt, N, 1024, E, G, wave_s); }
            meta_gemm(lds, XN, Wt, N, 1024, q, vcu, G, wave_s);
        REP_END(P + 0) }
        SEAM(P + 0);
        if (INA(1)) { PTRS(); REP_BEGIN(P + 1)
            if (layer == 0) {
                LAS int* ord = (LAS int*)(lds + ORD_OFF);
                constexpr int NSTREAM = 32;
                if (G % NSTREAM == 0) {
                    const int cps = G / NSTREAM, s = vcu / cps;
                    const int b = s >> 4, h = (s >> 1) & 7, c = s & 1;
                    gu32* qcnt = ctl + CW_QUEUE + 64 * s;
                    for (;;) {
                        if (wave_s == 0 && lane_id() == 0) ord[0] = (int)__hip_atomic_fetch_add(qcnt, 1u, RLX_AGENT);
                        __syncthreads();
                        const int i = __builtin_amdgcn_readfirstlane(ord[0]);
                        __syncthreads();
                        if (i >= 65) break;
                        attn_body::attn_unit<8, false, 2>(b, 2 * h + c, 2 * h, 64 - i, (const attn_body::bf16*)QB, (const attn_body::bf16*)KB, (const attn_body::bf16*)VB, (attn_body::bf16*)(c ? O1 : O0), nullptr, (char*)lds_raw, wave_s);
                    }
                } else {
                    for (int uid = vcu; uid < NSTREAM * 65; uid += G) { const int s = uid / 65, qb = 64 - uid % 65, b = s >> 4, h = (s >> 1) & 7, c = s & 1;
                        attn_body::attn_unit<8, false, 2>(b, 2 * h + c, 2 * h, qb, (const attn_body::bf16*)QB, (const attn_body::bf16*)KB, (const attn_body::bf16*)VB, (attn_body::bf16*)(c ? O1 : O0), nullptr, (char*)lds_raw, wave_s); }
                }
            } else {
                for (int r = gw; r < NBATCH * TREAL; r += NGW) { const int b = r / TREAL, pos = r - b * TREAL, row = b * TALLOC + pos;
                    const float* src = SIDE + (size_t)row * SIDE_W; const int h = lane >> 3, d4 = (lane & 7) * 4;
                    const f32x4 c = *(const f32x4*)(COS + pos * 32 + d4), s = *(const f32x4*)(SIN + pos * 32 + d4);
                    { const f32x4 x1 = *(const f32x4*)(src + h * 64 + d4), x2 = *(const f32x4*)(src + h * 64 + 32 + d4);
                      bf16* dst = QI + (size_t)row * 512 + h * 64 + d4; *(unsigned long long*)dst = pk4(x1 * c - x2 * s); *(unsigned long long*)(dst + 32) = pk4(x2 * c + x1 * s); }
                    { f32x4 k1 = *(const f32x4*)(src + 512 + d4), k2 = *(const f32x4*)(src + 544 + d4);
                      float ss = (k1.x * k1.x + k1.y * k1.y) + (k1.z * k1.z + k1.w * k1.w) + (k2.x * k2.x + k2.y * k2.y) + (k2.z * k2.z + k2.w * k2.w);
                      ss += __shfl_xor(ss, 1); ss += __shfl_xor(ss, 2); ss += __shfl_xor(ss, 4);
                      const float rr = 1.0f / sqrtf(ss * (1.f / 64.f) + RMS_EPS);
                      const f32x4 g1 = *(const f32x4*)(args.in[IN_IDX_KNORM] + d4), g2 = *(const f32x4*)(args.in[IN_IDX_KNORM] + 32 + d4);
                      k1 = k1 * rr * g1; k2 = k2 * rr * g2;
                      if (lane < 8) { bf16* dst = KI + (size_t)row * 64 + d4; *(unsigned long long*)dst = pk4(k1 * c - k2 * s); *(unsigned long long*)(dst + 32) = pk4(k2 * c + k1 * s); } }
                    if (lane < 8) WI[(size_t)row * 8 + lane] = src[576 + lane] * (0.35355339059327373f * 0.125f);
                }
            }
        REP_END(P + 1) }
        SEAM(P + 1);
        if (INA(2)) { PTRS(); REP_BEGIN(P + 2)
            if (layer == 0) {
                const int lane = lane_id();
                float lam;
                { const float a1 = args.in[IN_LQ1][lane] * args.in[IN_LK1][lane], a2 = args.in[IN_LQ2][lane] * args.in[IN_LK2][lane];
                  lam = expf(wave_sum(a1)) - expf(wave_sum(a2)) + LAMBDA_INIT0; }
                for (int r = gw; r < NBATCH * TREAL; r += NGW) { const int b = r / TREAL, pos = r - b * TREAL, row = b * TALLOC + pos;
                    const v4u* p0 = (const v4u*)(O0 + (size_t)row * 1024 + lane * 16); const v4u* p1 = (const v4u*)(O1 + (size_t)row * 1024 + lane * 16);
                    const v4u a0 = p0[0], a1 = p0[1], b0 = p1[0], b1 = p1[1];
                    const unsigned aw[8] = {a0.x, a0.y, a0.z, a0.w, a1.x, a1.y, a1.z, a1.w}, bw[8] = {b0.x, b0.y, b0.z, b0.w, b1.x, b1.y, b1.z, b1.w};
                    float o[16]; float ss = 0.f;
#pragma unroll
                    for (int i = 0; i < 8; ++i) { o[2 * i] = __uint_as_float(aw[i] << 16) - lam * __uint_as_float(bw[i] << 16); o[2 * i + 1] = __uint_as_float(aw[i] & 0xffff0000u) - lam * __uint_as_float(bw[i] & 0xffff0000u);
                        ss += o[2 * i] * o[2 * i] + o[2 * i + 1] * o[2 * i + 1]; }
                    ss += __shfl_xor(ss, 1); ss += __shfl_xor(ss, 2); ss += __shfl_xor(ss, 4);
                    const float rr = (1.0f - LAMBDA_INIT0) / sqrtf(ss * (1.f / 128.f) + RMS_EPS);
                    const float* sg = args.in[IN_SUBLN] + (lane & 7) * 16; unsigned w[8];
#pragma unroll
                    for (int i = 0; i < 8; ++i) w[i] = pk2(o[2 * i] * rr * sg[2 * i], o[2 * i + 1] * rr * sg[2 * i + 1]);
                    v4u* dst = (v4u*)(QB + (size_t)row * 1024 + lane * 16); dst[0] = v4u{w[0], w[1], w[2], w[3]}; dst[1] = v4u{w[4], w[5], w[6], w[7]};
                }
            } else {
                LAS unsigned* hist = (LAS unsigned*)lds;
                LAS unsigned* mrow = (LAS unsigned*)lds;
                LAS unsigned* st_klo = (LAS unsigned*)(lds + TK_ST_OFF), *st_khi = st_klo + 32, *st_cab = st_klo + 64, *st_done = st_klo + 96, *tie_cnt = st_klo + 128, *st_shift = st_klo + 160, *st_kmax = st_klo + 192, *st_need = st_klo + 224, *cand_cnt = st_klo + 256, *st_flag = st_klo + 288;
                LAS unsigned* tie_key = (LAS unsigned*)(lds + TK_TIE_OFF), *tie_pos = tie_key + 32 * TIE_CAP;
                LAS unsigned char* qlds = lds + TK_Q_OFF;
                unsigned long long* cand = (unsigned long long*)XN + (size_t)vcu * 32 * TK_CAND_CAP;
                unsigned* smp = (unsigned*)cand;
                constexpr int NUNIT = 2 * 513;
                for (int round = 0;; ++round) {
                    int tl = wave_s * 64 + lane_id(); asm volatile("" : "+v"(tl));
                    const int lane = tl & 63, wave = __builtin_amdgcn_readfirstlane(tl >> 6), qi = lane & 31, hi = lane >> 5;
                    const int rank = round * G + ((round & 1) ? (G - 1 - vcu) : vcu); if (rank >= NUNIT) break;
#ifdef TK_ABL
                    if (rep_ == 0 && (TK_ABL & 256) && round == 0) continue;
#endif
                    const int b = rank & 1, u = 512 - (rank >> 1), q_lo = 32 * u, rowbase = b * TALLOC, pos_q = q_lo + qi, NB = u + 1;
                    const bool sel = u >= 8, active = pos_q < TREAL;
                    if (!sel) {
                        for (int i = tl; i < 32 * 130; i += NWAVES * 64) { const int q = i / 130, w4 = (i - q * 130) * 4, pos = q_lo + q; unsigned wd[4];
#pragma unroll
                            for (int e = 0; e < 4; ++e) { const int lo32 = 32 * (w4 + e); wd[e] = pos >= lo32 + 31 ? 0xffffffffu : (pos < lo32 ? 0u : ((2u << (pos - lo32)) - 1u)); }
                            *(v4u*)(MASK + (size_t)(rowbase + pos) * MWORDS + w4) = v4u{wd[0], wd[1], wd[2], wd[3]}; }
                        continue;
                    }
                    const int prow = active ? pos_q : TREAL - 1;
                    DILS_B(1);
                    float wq[8];
                    { const f32x4 w0 = *(const f32x4*)(WI + (size_t)(rowbase + prow) * 8), w1 = *(const f32x4*)(WI + (size_t)(rowbase + prow) * 8 + 4);
                      wq[0] = 0.5f * w0.x; wq[1] = 0.5f * w0.y; wq[2] = 0.5f * w0.z; wq[3] = 0.5f * w0.w; wq[4] = 0.5f * w1.x; wq[5] = 0.5f * w1.y; wq[6] = 0.5f * w1.z; wq[7] = 0.5f * w1.w; }
                    { const bf16* qp = QI + (size_t)(rowbase + prow) * 512 + hi * 8 + wave * 64;
#pragma unroll
                      for (int kk = 0; kk < 4; ++kk) *(LAS bf16x8*)(qlds + (wave * 4 + kk) * 1024 + lane * 16) = *(const bf16x8*)(qp + kk * 16); }
                    if (wave < 4) {
                        const bf16* qp = QI + (size_t)(rowbase + prow) * 512 + hi * 8 + wave * 16; float a[8];
#pragma unroll
                        for (int e = 0; e < 8; ++e) a[e] = 0.f;
#pragma unroll
                        for (int h = 0; h < 8; ++h) { const v4u qv = *(const v4u*)(qp + h * 64); const unsigned qw[4] = {qv.x, qv.y, qv.z, qv.w};
#pragma unroll
                            for (int e = 0; e < 4; ++e) { a[2 * e] += wq[h] * __uint_as_float(qw[e] << 16); a[2 * e + 1] += wq[h] * __uint_as_float(qw[e] & 0xffff0000u); } }
                        unsigned ph[4], pl[4];
#pragma unroll
                        for (int e = 0; e < 4; ++e) { const unsigned h0 = f2bf(a[2 * e]), h1 = f2bf(a[2 * e + 1]);
                            ph[e] = h0 | (h1 << 16); pl[e] = pk2(a[2 * e] - __uint_as_float(h0 << 16), a[2 * e + 1] - __uint_as_float(h1 << 16)); }
                        *(LAS v4u*)(qlds + (8 * 4 + wave) * 1024 + lane * 16) = v4u{ph[0], ph[1], ph[2], ph[3]}; *(LAS v4u*)(qlds + (9 * 4 + wave) * 1024 + lane * 16) = v4u{pl[0], pl[1], pl[2], pl[3]};
                    }
#ifdef TK_ABL
                    const int tk_abl = (rep_ == 0) ? TK_ABL : 0;
#else
                    constexpr int tk_abl = 0;
#endif
                    const bool use_sample = u >= 40;
                    if (tl < 32) { const bool inact = q_lo + tl >= TREAL; unsigned need = (unsigned)TOPK_NM;
                        if (use_sample) { const float m = 240.f * 1024.f / (float)(q_lo + tl - 15); need = (unsigned)(m + 4.f * sqrtf(m) + 2.f); }
                        st_klo[tl] = 0u; st_khi[tl] = 0xffffffffu; st_cab[tl] = 0u; st_done[tl] = inact ? 1u : 0u; tie_cnt[tl] = 0u; st_shift[tl] = 22u; st_kmax[tl] = 0u; st_need[tl] = need; cand_cnt[tl] = 0u;
                        if (tl == 0) st_flag[0] = use_sample ? 0u : 1u; }
                    __syncthreads();
                    DILS_E(1);
                    unsigned klo_q = 0u, khi_q = 0xffffffffu;
                    { int stage = use_sample ? 0 : 1; bool collected = false;
                        for (int it = 0; it < 16; ++it) {
                            DILS_B(7);
                            { unsigned z = 0u; asm volatile("" : "+v"(z)); for (int i = tl; i < 32 * TK_HS / 4; i += NWAVES * 64) ((LAS v4u*)hist)[i] = v4u{z, z, z, z}; }
                            klo_q = st_klo[qi]; khi_q = st_khi[qi]; const bool done_q = st_done[qi] != 0u; const unsigned shift_q = st_shift[qi];
                            const bool collect = use_sample && stage == 1 && !collected;
                            __syncthreads();
                            DILS_E(7);
                            DILS_B(2); DILS_B(3);
                            if (stage == 0 && it > 0) {
                                int ll = lane; asm volatile("" : "+v"(ll));
                                for (int qq = 4 * wave; qq < 4 * wave + 4; ++qq) { if (st_done[qq] != 0u) continue; const unsigned kl = st_klo[qq], kh = st_khi[qq], sh = st_shift[qq]; unsigned ky[16];
#pragma unroll
                                    for (int k = 0; k < 16; ++k) ky[k] = __hip_atomic_load(smp + qq * 1024 + 64 * k + ll, __ATOMIC_RELAXED, __HIP_MEMORY_SCOPE_AGENT);
#pragma unroll
                                    for (int k = 0; k < 16; ++k) if (ky[k] >= kl && ky[k] <= kh) { unsigned bin = (ky[k] - kl) >> sh; bin = bin > 1023u ? 1023u : bin;
                                        __hip_atomic_fetch_add(hist + qq * TK_HS + (bin >> 1), 1u << ((bin & 1u) * 16u), __ATOMIC_RELAXED, __HIP_MEMORY_SCOPE_WORKGROUP); } }
                            } else {
                                tk_sweep(lds, KI, cand, wq, wave, lane, stage ? NB : 32, stage ? 0 : 32 * (u - 1), smp, u, rowbase, pos_q, klo_q, khi_q, done_q, shift_q, true, collect, stage == 0);
                                if (stage == 0) asm volatile("s_waitcnt vmcnt(0)" ::: "memory");
                            }
                            if (stage == 0) DILS_E(2); else DILS_E(3);
                            if (collect) collected = true;
                            DILS_B(4);
                            if ((tk_abl & 1) && stage == 1) { __syncthreads(); break; }
                            __syncthreads();
                            { unsigned hw[4][8], sm[4], suf[4], dn[4];
#pragma unroll
                              for (int j = 0; j < 4; ++j) { dn[j] = st_done[4 * wave + j];
#pragma unroll
                                  for (int i = 0; i < 8; ++i) hw[j][i] = hist[(4 * wave + j) * TK_HS + 8 * lane + i]; }
#pragma unroll
                              for (int j = 0; j < 4; ++j) { unsigned t_ = 0u;
#pragma unroll
                                  for (int i = 0; i < 8; ++i) t_ += (hw[j][i] & 0xffffu) + (hw[j][i] >> 16);
                                  sm[j] = t_; suf[j] = t_; }
#pragma unroll
                              for (int off = 1; off < 64; off <<= 1) {
#pragma unroll
                                  for (int j = 0; j < 4; ++j) { const unsigned t = (unsigned)__shfl_down((int)suf[j], off); if (lane + off < 64) suf[j] += t; } }
#pragma unroll
                              for (int j = 0; j < 4; ++j) { const int qq = 4 * wave + j;
                                if (dn[j] != 0u) continue;
                                const unsigned need = st_need[qq] - st_cab[qq], total = (unsigned)__shfl((int)suf[j], 0);
                                if (total < need) {
                                    if (lane == 0) { const unsigned ok = st_klo[qq]; st_cab[qq] += total; st_khi[qq] = ok - 1u; st_klo[qq] = 0u; st_flag[0] = 1u;
                                        const int wb = 32 - __builtin_clz((ok - 1u) | 1u); st_shift[qq] = (unsigned)(wb > 10 ? wb - 10 : 0); if (ok == 0u) st_done[qq] = 1u; }
                                } else {
                                    const unsigned long long bal = __ballot(suf[j] >= need);
                                    const int Ls = 63 - __builtin_clzll(bal | 1ull);
                                    if (lane == Ls) { unsigned cum = suf[j] - sm[j], above = 0u, cnt = 0u; int jb = 0; bool found = false;
#pragma unroll
                                        for (int i = 15; i >= 0; --i) { const unsigned ci = (i & 1) ? (hw[j][i >> 1] >> 16) : (hw[j][i >> 1] & 0xffffu); if (!found) { if (cum + ci >= need) { found = true; jb = i; above = cum; cnt = ci; } else cum += ci; } }
                                        const unsigned sh = st_shift[qq], jbin = (unsigned)(16 * lane + jb), klo_n = st_klo[qq] + (jbin << sh), kho = st_khi[qq];
                                        unsigned khi_n = klo_n + ((1u << sh) - 1u); if (khi_n < klo_n || khi_n > kho || jbin == 1023u) khi_n = kho;
                                        st_cab[qq] += above; st_klo[qq] = klo_n; st_khi[qq] = khi_n;
                                        st_done[qq] = (cnt <= (stage == 0 ? 4u : (unsigned)TIE_CAP) || khi_n == klo_n) ? 1u : 0u;
                                        const unsigned wdt = khi_n - klo_n; const int wb = 32 - __builtin_clz(wdt | 1u); st_shift[qq] = (unsigned)(wb > 10 ? wb - 10 : 0); }
                                }
                              }
                            }
                            __syncthreads();
                            DILS_E(4);
                            if (__all(st_done[qi] != 0u)) {
                                if (stage != 0) break;
                                __syncthreads();
                                if (tl < 32) { const bool inact = q_lo + tl >= TREAL; const unsigned L = st_klo[tl], km = st_kmax[tl]; const unsigned span = km > L ? km - L : 1u;
                                    const unsigned w2 = span > 0x7fffffffu ? 0xffffffffu : 2u * span; int sh = 32 - __builtin_clz(w2 | 1u) - 10; sh = sh < 0 ? 0 : (sh > 22 ? 22 : sh);
                                    st_klo[tl] = L; st_khi[tl] = 0xffffffffu; st_cab[tl] = 0u; st_done[tl] = inact ? 1u : 0u; st_shift[tl] = (unsigned)sh; st_need[tl] = (unsigned)TOPK_NM; }
                                stage = 1;
                                __syncthreads();
                            }
                        }
                    }
                    DILS_B(5);
                    { bool redo = (st_flag[0] != 0u || !__all(cand_cnt[qi] <= (unsigned)TK_CAND_CAP)) && !(tk_abl & 2);
                      if (redo) { __syncthreads(); if (tl < 32) cand_cnt[tl] = 0u; __syncthreads();
                          tk_sweep(lds, KI, cand, wq, wave, lane, NB, 0, smp, u, rowbase, pos_q, st_klo[qi], 0xffffffffu, !active, 0u, false, true, false); } }
                    DILS_E(5);
                    DILS_B(6);
                    asm volatile("s_waitcnt vmcnt(0)" ::: "memory");
                    for (int i = tl; i < 32 * MWORDS; i += NWAVES * 64) mrow[i] = ((i % MWORDS) == 0) ? 0xffffu : 0u;
                    __syncthreads();
                    int lf_ = lane; asm volatile("" : "+v"(lf_));
                    if (!(tk_abl & 4))
                    for (int q = 4 * wave; q < 4 * wave + 4; ++q) { const int lane = lf_;
                        if (q_lo + q >= TREAL) continue;
                        unsigned n = cand_cnt[q]; n = n > (unsigned)TK_CAND_CAP ? (unsigned)TK_CAND_CAP : n; const unsigned kl = st_klo[q], kh = st_khi[q];
                        const unsigned long long* cq = cand + (size_t)q * TK_CAND_CAP;
                        for (unsigned base = 0; base < n; base += 256u) {
                            unsigned long long e[4];
#pragma unroll
                            for (int k = 0; k < 4; ++k) { const unsigned i = base + 64u * k + (unsigned)lane; e[k] = i < n ? __hip_atomic_load(cq + i, __ATOMIC_RELAXED, __HIP_MEMORY_SCOPE_AGENT) : 0ull; }
#pragma unroll
                            for (int k = 0; k < 4; ++k) { const unsigned i = base + 64u * k + (unsigned)lane; const unsigned key = (unsigned)e[k], kpos = (unsigned)(e[k] >> 32);
                                if (i < n) { if (key > kh) __hip_atomic_fetch_or(mrow + q * MWORDS + (kpos >> 5), 1u << (kpos & 31u), __ATOMIC_RELAXED, __HIP_MEMORY_SCOPE_WORKGROUP);
                                    else if (key >= kl) { const unsigned ix = __hip_atomic_fetch_add(tie_cnt + q, 1u, __ATOMIC_RELAXED, __HIP_MEMORY_SCOPE_WORKGROUP);
                                        if (ix < (unsigned)TIE_CAP) { tie_key[q * TIE_CAP + ix] = key; tie_pos[q * TIE_CAP + ix] = kpos; } } } }
                        }
                        asm volatile("s_waitcnt lgkmcnt(0)" ::: "memory");
                        unsigned cnt = tie_cnt[q]; cnt = cnt > (unsigned)TIE_CAP ? (unsigned)TIE_CAP : cnt; const unsigned ntake = (unsigned)TOPK_NM - st_cab[q];
                        const bool have = (unsigned)lane < cnt; const unsigned ki = have ? tie_key[q * TIE_CAP + lane] : 0u, pi = have ? tie_pos[q * TIE_CAP + lane] : 0u; unsigned rk = 0u;
                        for (unsigned j2 = 0; j2 < cnt; ++j2) { const unsigned kj = (unsigned)__builtin_amdgcn_readlane((int)ki, (int)j2), pj = (unsigned)__builtin_amdgcn_readlane((int)pi, (int)j2); rk += (kj > ki || (kj == ki && pj < pi)) ? 1u : 0u; }
                        if (have && rk < ntake && !(tk_abl & 8)) __hip_atomic_fetch_or(mrow + q * MWORDS + (pi >> 5), 1u << (pi & 31u), __ATOMIC_RELAXED, __HIP_MEMORY_SCOPE_WORKGROUP);
                    }
                    __syncthreads();
                    for (int i = tl; i < 32 * 130; i += NWAVES * 64) { const int q = i / 130, w4 = (i - q * 130) * 4;
                        if (q_lo + q < TREAL) *(v4u*)(MASK + (size_t)(rowbase + q_lo + q) * MWORDS + w4) = *(const LAS v4u*)(mrow + q * MWORDS + w4); }
                    __syncthreads();
                    DILS_E(6);
                }
            }
        REP_END(P + 2) }
        SEAM(P + 2);
        if (layer == 1) {
            if (INA(3)) { PTRS(); REP_BEGIN(P + 3)
                LAS int* ord = (LAS int*)(lds + ORD_OFF);
                constexpr int NSTREAM = 32;
                if (G % NSTREAM == 0) {
                    const int cps = G / NSTREAM, s = vcu / cps;
                    gu32* qcnt = ctl + CW_QUEUE + 64 * (32 + s);
                    for (;;) {
                        if (wave_s == 0 && lane_id() == 0) ord[0] = (int)__hip_atomic_fetch_add(qcnt, 1u, RLX_AGENT);
                        __syncthreads();
                        const int i = __builtin_amdgcn_readfirstlane(ord[0]);
                        __syncthreads();
                        if (i >= 65) break;
                        attn_body::attn_unit<8, true, 1>(s >> 4, s & 15, s & 15, 64 - i, (const attn_body::bf16*)QB, (const attn_body::bf16*)KB, (const attn_body::bf16*)VB, (attn_body::bf16*)XN, MASK, (char*)lds_raw, wave_s);
                    }
                } else {
                    for (int uid = vcu; uid < NSTREAM * 65; uid += G) { const int s = uid / 65, qb = 64 - uid % 65;
                        attn_body::attn_unit<8, true, 1>(s >> 4, s & 15, s & 15, qb, (const attn_body::bf16*)QB, (const attn_body::bf16*)KB, (const attn_body::bf16*)VB, (attn_body::bf16*)XN, MASK, (char*)lds_raw, wave_s); }
                }
            REP_END(P + 3) }
            SEAM(P + 3);
        } else { STAMP(P + 4); }
        if (INA(4)) { PTRS(); REP_BEGIN(P + 4)
            const QuadResid q{H, (rep_ & 1) ? -1.f : 1.f};
            const bf16* Wt = layer == 0 ? WO1_T : WO2_T;
            const bf16* Ain = layer == 0 ? QB : XN;
            run_gemm(lds, Ain, Wt, 1024, 1024, q, G, wave_s);
            meta_gemm(lds, Ain, Wt, 1024, 1024, q, vcu, G, wave_s);
        REP_END(P + 4) }
        SEAM(P + 4);
        if (INA(5)) { PTRS(); REP_BEGIN(P + 5)
            for (int r = gw; r < NBATCH * TREAL; r += NGW) { const int b = r / TREAL, pos = r - b * TREAL, row = b * TALLOC + pos;
                rms_row_bf16(H + (size_t)row * 1024, args.in[IN_FFN_NORM] + layer * 1024, XN + (size_t)row * 1024, nullptr, lane); }
        REP_END(P + 5) }
        SEAM(P + 5);
        if (INA(6)) { PTRS(); const bf16* WU = (const bf16*)(ws + WS_WUP + layer * 11 * MiB); bf16* ACTF = (bf16*)(ws + WS_Q);
            const float* cw = args.in[IN_CONV_W] + (size_t)layer * 3 * 2 * FFN_H; const float* cb = args.in[IN_CONV_B] + (size_t)layer * 2 * FFN_H;
            unsigned char* dob = (unsigned char*)outp;
            REP_BEGIN(P + 6)
            const EpiFfn E{(bf16*)(dob + DO_TS) + (size_t)blockIdx.x * 65536, (bf16*)(dob + DO_HL), (bf16*)(dob + DO_HF), ACTF, cw, cb};
            run_gemm_epi(lds, XN, WU, 2 * FFN_H, 1024, E, G, wave_s);
            const QuadMetaU qm{(bf16*)(dob + DO_UM)}; meta_gemm(lds, XN, WU, 2 * FFN_H, 1024, qm, vcu, G, wave_s);
            REP_END(P + 6) }
        SEAM(P + 6);
        if (INA(7)) { PTRS(); bf16* ACTF = (bf16*)(ws + WS_Q); unsigned char* dob = (unsigned char*)outp;
            const GAS bf16* HL = (const GAS bf16*)(dob + DO_HL); const GAS bf16* HF = (const GAS bf16*)(dob + DO_HF); const GAS bf16* UM = (const GAS bf16*)(dob + DO_UM);
            const float* cw = args.in[IN_CONV_W] + (size_t)layer * 3 * 2 * FFN_H; const float* cb = args.in[IN_CONV_B] + (size_t)layer * 2 * FFN_H;
            constexpr int NC = FFN_H / 8, NROW = 32 + 256;
            for (int it = gtid; it < NROW * NC; it += NGT) { const int rr = it / NC, h8 = (it - rr * NC) * 8, scol = 256 * (h8 >> 7) + (h8 & 127);
                const GAS bf16* src[3]; int row;
                if (rr < 32) { const int b = rr >> 4, j = rr & 15; row = b * TALLOC + j;
                    src[2] = UM + (size_t)rr * (2 * FFN_H); src[1] = j >= 1 ? UM + (size_t)(rr - 1) * (2 * FFN_H) : nullptr; src[0] = j >= 2 ? UM + (size_t)(rr - 2) * (2 * FFN_H) : nullptr; }
                else { const int q = rr - 32, pm = q >> 1, r01 = q & 1; row = pg8::arow(pm) + r01;
                    const GAS bf16* pl0 = (pm & 63) ? HL + (size_t)((pm - 1) * 2 + 0) * (2 * FFN_H) : UM + (size_t)((pm >> 6) * 16 + 14) * (2 * FFN_H);
                    const GAS bf16* pl1 = (pm & 63) ? HL + (size_t)((pm - 1) * 2 + 1) * (2 * FFN_H) : UM + (size_t)((pm >> 6) * 16 + 15) * (2 * FFN_H);
                    const GAS bf16* f0 = HF + (size_t)(pm * 2 + 0) * (2 * FFN_H); const GAS bf16* f1 = HF + (size_t)(pm * 2 + 1) * (2 * FFN_H);
                    src[2] = r01 ? f1 : f0; src[1] = r01 ? f0 : pl1; src[0] = r01 ? pl1 : pl0; }
                float ag[8], av[8];
                { const f32x4 b0 = *(const GAS f32x4*)(cb + h8), b1 = *(const GAS f32x4*)(cb + h8 + 4), d0 = *(const GAS f32x4*)(cb + FFN_H + h8), d1 = *(const GAS f32x4*)(cb + FFN_H + h8 + 4);
                  ag[0] = b0.x; ag[1] = b0.y; ag[2] = b0.z; ag[3] = b0.w; ag[4] = b1.x; ag[5] = b1.y; ag[6] = b1.z; ag[7] = b1.w; av[0] = d0.x; av[1] = d0.y; av[2] = d0.z; av[3] = d0.w; av[4] = d1.x; av[5] = d1.y; av[6] = d1.z; av[7] = d1.w; }
#pragma unroll
                for (int j = 0; j < 3; ++j) { if (src[j] != nullptr) {
                    const v4u ug = *(const GAS v4u*)(src[j] + scol), uv = *(const GAS v4u*)(src[j] + scol + 128);
                    const float* wgp = cw + (size_t)j * 2 * FFN_H + h8; const float* wvp = wgp + FFN_H;
                    const f32x4 g0 = *(const GAS f32x4*)wgp, g1 = *(const GAS f32x4*)(wgp + 4), v0 = *(const GAS f32x4*)wvp, v1 = *(const GAS f32x4*)(wvp + 4);
                    const unsigned ugw[4] = {ug.x, ug.y, ug.z, ug.w}, uvw[4] = {uv.x, uv.y, uv.z, uv.w}; const float gw8[8] = {g0.x, g0.y, g0.z, g0.w, g1.x, g1.y, g1.z, g1.w}, vw8[8] = {v0.x, v0.y, v0.z, v0.w, v1.x, v1.y, v1.z, v1.w};
#pragma unroll
                    for (int e = 0; e < 4; ++e) { ag[2 * e] += gw8[2 * e] * __uint_as_float(ugw[e] << 16); ag[2 * e + 1] += gw8[2 * e + 1] * __uint_as_float(ugw[e] & 0xffff0000u);
                        av[2 * e] += vw8[2 * e] * __uint_as_float(uvw[e] << 16); av[2 * e + 1] += vw8[2 * e + 1] * __uint_as_float(uvw[e] & 0xffff0000u); } } }
                unsigned w[4];
#pragma unroll
                for (int e = 0; e < 4; ++e) { const float x0 = ag[2 * e], x1 = ag[2 * e + 1]; w[e] = pk2(silu_mul(x0, av[2 * e]), silu_mul(x1, av[2 * e + 1])); }
                *(GAS v4u*)((GAS bf16*)ACTF + (size_t)row * FFN_H + h8) = v4u{w[0], w[1], w[2], w[3]}; }
        }
        SEAM(P + 7);
        if (INA(8)) { PTRS(); const bf16* WD = (const bf16*)(ws + WS_WDN + layer * (11 * MiB / 2)); const bf16* ACTF = (const bf16*)(ws + WS_Q); REP_BEGIN(P + 8)
            const QuadResid q{H, (rep_ & 1) ? -1.f : 1.f}; run_gemm(lds, ACTF, WD, 1024, FFN_H, q, G, wave_s); meta_gemm(lds, ACTF, WD, 1024, FFN_H, q, vcu, G, wave_s);
        REP_END(P + 8) }
        SEAM(P + 8);
        if (INA(11)) { PTRS(); REP_BEGIN(P + 11)
            if (layer == 0) {
                for (int r = gw; r < NBATCH * TREAL; r += NGW) { const int b = r / TREAL, pos = r - b * TREAL, row = b * TALLOC + pos;
                    rms_row_bf16(H + (size_t)row * 1024, args.in[IN_DSA_NORM], XN + (size_t)row * 1024, nullptr, lane); }
                for (int r = gw; r < 2 * NBATCH * (TALLOC - TREAL); r += NGW) { const int which = r / (NBATCH * (TALLOC - TREAL)), rr = r % (NBATCH * (TALLOC - TREAL)), b = rr / (TALLOC - TREAL), pos = TREAL + rr % (TALLOC - TREAL);
                    v4u* p = (v4u*)(KB + (size_t)which * QKV_STRIDE + (size_t)(b * TALLOC + pos) * 1024); unsigned z = 0u; asm volatile("" : "+v"(z)); p[lane] = v4u{z, z, z, z}; p[lane + 64] = v4u{z, z, z, z}; }
            } else {
                for (int r = gw; r < NBATCH * SEQL; r += NGW) { const int b = r / SEQL, t = r - b * SEQL;
                    const f32x4* xr = (const f32x4*)(H + (size_t)(b * TALLOC + NMETA + t) * 1024) + lane; f32x4 v[4]; float s = 0.f;
#pragma unroll
                    for (int j = 0; j < 4; ++j) { v[j] = xr[64 * j]; s += (v[j].x * v[j].x + v[j].y * v[j].y) + (v[j].z * v[j].z + v[j].w * v[j].w); }
                    float rr = 1.0f / sqrtf(wave_sum(s) * (1.f / 1024.f) + RMS_EPS);
                    const f32x4* gr = (const f32x4*)args.in[IN_FINAL_NORM] + lane; f32x4* o = (f32x4*)(args.out + (size_t)r * 1024) + lane;
#ifdef DIAG_A
                    { const unsigned long long* stp = (const unsigned long long*)(args.ws + 65536); const float tot = (float)(__hip_atomic_load(stp + 24, __ATOMIC_RELAXED, __HIP_MEMORY_SCOPE_AGENT) - __hip_atomic_load(stp + 0, __ATOMIC_RELAXED, __HIP_MEMORY_SCOPE_AGENT));
                      const float fa = (float)(__hip_atomic_load(stp + DIAG_A + 1, __ATOMIC_RELAXED, __HIP_MEMORY_SCOPE_AGENT) - __hip_atomic_load(stp + DIAG_A, __ATOMIC_RELAXED, __HIP_MEMORY_SCOPE_AGENT)) / tot;
                      const float fb = (float)(__hip_atomic_load(stp + DIAG_B + 1, __ATOMIC_RELAXED, __HIP_MEMORY_SCOPE_AGENT) - __hip_atomic_load(stp + DIAG_B, __ATOMIC_RELAXED, __HIP_MEMORY_SCOPE_AGENT)) / tot;
                      rr *= 1.f + sqrtf(fa); if (r == 0 && lane == 0) v[0].x += (10.f + 100.f * fb) / (rr * gr[0].x); }
#endif
#pragma unroll
                    for (int j = 0; j < 4; ++j) o[64 * j] = v[j] * rr * gr[64 * j];
                }
            }
        REP_END(P + 11) }
        if (layer == 0) SEAM(P + 11);
    }
    if (full_ < FULLREP) xcd_barrier(bar, wave_s);
    }
#undef IN
#undef INA
#undef SEAM
}

#ifndef MK_PER_PHASE
#define MK_PER_PHASE 0
#endif
extern "C" void kernel_launch(void* const* d_in, const int* in_sizes, int n_in, void* d_out, int out_size, void* d_ws, size_t ws_size, hipStream_t stream) {
    static int grid = 0;
    if (grid == 0) {
        if (n_in != 20 || out_size != NBATCH * SEQL * DMODEL || ws_size < WS_END) { fprintf(stderr, "kernel_launch: unexpected problem (n_in %d, out %d, ws %zu)\n", n_in, out_size, ws_size); grid = -1; return; }
        int dev = 0, cus = 0, per_cu = 0;
        if (hipGetDevice(&dev) != hipSuccess || hipDeviceGetAttribute(&cus, hipDeviceAttributeMultiprocessorCount, dev) != hipSuccess) { grid = -1; return; }
        if (hipFuncSetAttribute((const void*)fwd, hipFuncAttributeMaxDynamicSharedMemorySize, LDS_BYTES) != hipSuccess) { fprintf(stderr, "kernel_launch: hipFuncSetAttribute failed\n"); grid = -1; return; }
        if (hipOccupancyMaxActiveBlocksPerMultiprocessor(&per_cu, (const void*)fwd, NWAVES * 64, LDS_BYTES) != hipSuccess || per_cu < 1) { fprintf(stderr, "kernel_launch: occupancy query says %d\n", per_cu); }
        (void)hipGetLastError();
        grid = cus;
    }
    if (grid < 0) return;
    if (hipMemsetAsync((char*)d_ws + WS_CTL, 0, CTL_ZERO_BYTES, stream) != hipSuccess) return;
    Args a{};
    for (int i = 0; i < 20; ++i) a.in[i] = (const float*)d_in[i];
    a.out = (float*)d_out; a.ws = (unsigned char*)d_ws;
#if MK_PER_PHASE
    for (int p = 0; p < N_PHASES; ++p) { if (p == 4) continue; a.ph_lo = p; a.ph_hi = p + 1; hipLaunchKernelGGL(fwd, dim3(grid), dim3(NWAVES * 64), LDS_BYTES, stream, a); }
#else
    a.ph_lo = 0; a.ph_hi = N_PHASES;
    hipLaunchKernelGGL(fwd, dim3(grid), dim3(NWAVES * 64), LDS_BYTES, stream, a);
#ifdef HOST_TWICE
    (void)hipMemsetAsync((char*)d_ws + WS_CTL, 0, CTL_ZERO_BYTES, stream);
    hipLaunchKernelGGL(fwd, dim3(grid), dim3(NWAVES * 64), LDS_BYTES, stream, a);
#endif
#endif
}
```

```cpp
#include <hip/hip_runtime.h>
#include <hip/hip_bf16.h>
#include <cstdio>
#include <cstdint>
#include <cmath>
__device__ __forceinline__ int lane_id() { int r; asm volatile("v_mbcnt_lo_u32_b32 %0, -1, 0\n\tv_mbcnt_hi_u32_b32 %0, -1, %0" : "=v"(r)); return r; }
#ifdef DILSEC
#define DILS_B(n) const unsigned long long dils_t0_##n = (DILSEC == (n)) ? __builtin_amdgcn_s_memrealtime() : 0ull
#define DILS_E(n) do { if (DILSEC == (n)) { const unsigned long long t1_ = __builtin_amdgcn_s_memrealtime(), d_ = t1_ - dils_t0_##n; while (__builtin_amdgcn_s_memrealtime() - t1_ < d_) __builtin_amdgcn_s_sleep(2); } } while (0)
#else
#define DILS_B(n)
#define DILS_E(n) do { } while (0)
#endif
namespace pg8 {
#define PG8_LAS __attribute__((address_space(3)))
typedef unsigned short bf16_t;
typedef short bf16x8 __attribute__((ext_vector_type(8)));
typedef float f32x4 __attribute__((ext_vector_type(4)));
typedef unsigned u32x4 __attribute__((ext_vector_type(4)));
constexpr int BM = 256, BK = 64, HALF = 128, HTB = HALF * BK * 2  , STAGE_BYTES = 8 * HTB, NXCD = 8, WGM = 8;

__host__ __device__ __forceinline__ int lds_byte(int r, int c) { const int st = (r >> 4) * 2 + (c >> 5), rr = r & 15, cc = c & 31, ob = rr * 64 + cc * 2; return st * 1024 + (ob ^ (((ob >> 9) & 1) << 5)); }
__host__ __device__ __forceinline__ void stage_rc(int b, int& R, int& C) { const int st = b / 1024, sb = b % 1024, swz = sb ^ (((sb >> 9) & 1) << 5); R = (st >> 1) * 16 + swz / 64; C = (st & 1) * 32 + (swz % 64) / 2; }
__host__ __device__ __forceinline__ int perm32(int rho) { const int n = rho >> 4, i = rho & 15; return 8 * (i >> 2) + 4 * n + (i & 3); }

__host__ __device__ __forceinline__ int arow(int pm) { return (pm >> 6) * 16640 + 16 + ((pm & 63) << 8); }
struct Unit { int pm, pn; };
struct Gemm { const bf16_t* A; const bf16_t* Bt; int M, N, K; };

struct StaticOrder {
    int nM, nN, nwg, G, c;
    __host__ __device__ void init(int M, int N, int G_, int c_) { nM = M / BM; nN = N / BM; nwg = nM * nN; G = G_; c = c_; }
    __host__ __device__ bool next(int i, Unit& u) const {
        const long L = (long)i * G + c; if (L >= nwg) return false;
        int wgid = (int)L; { const int q = nwg / NXCD, r = nwg % NXCD, xcd = wgid % NXCD, off = wgid / NXCD; wgid = (xcd < r ? xcd * (q + 1) : r * (q + 1) + (xcd - r) * q) + off; }
        const int nig = WGM * nN, gid = wgid / nig, fm = gid * WGM, gsz = (nM - fm) < WGM ? (nM - fm) : WGM;
        u.pm = fm + ((wgid % nig) % gsz); u.pn = (wgid % nig) / gsz; return true;
    }
    __device__ __forceinline__ void a_ready(const Unit&) const {}
    __device__ __forceinline__ void done(const Unit&) const {}
};
__device__ __forceinline__ unsigned cvt_pk_bf16(float lo, float hi) { unsigned r; asm volatile("v_cvt_pk_bf16_f32 %0, %1, %2" : "=v"(r) : "v"(lo), "v"(hi)); return r; }
template <class Epi, class Sched, bool ALIGN_EPI = false, bool SP2 = false>
__device__ __forceinline__ void gemm_phase(PG8_LAS unsigned char* lds, const Gemm g, const Sched& S, const Epi& E, const int wv_) {
    int tid_ = wv_ * 64 + lane_id(); asm volatile("" : "+v"(tid_));
    const int tid = tid_, wid = __builtin_amdgcn_readfirstlane(tid >> 6), lane = tid & 63, wr = wid >> 2, wc = wid & 3, fr = lane & 15, fq = lane >> 4;
    const int K = g.K, nt = K / BK;
    unsigned voffA[2], voffB[2];
#pragma unroll
    for (int i = 0; i < 2; ++i) { int R, C; stage_rc(tid * 16 + i * 8192, R, C); const int Rb = Epi::PERM ? ((R & ~31) + perm32(R & 31)) : R;
        voffA[i] = (unsigned)(R * K + C) * 2u; voffB[i] = (unsigned)(Rb * K + C) * 2u; }
    const size_t kstep = (size_t)(BK * 2);
    const size_t hstep = (size_t)HALF * K * 2;
    const size_t tstep = 2 * hstep;
    const unsigned ldsw = (unsigned)wid * 1024u;
    const int aoff = lds_byte(wr * 64 + fr, fq * 8), boff = lds_byte(wc * 32 + fr, fq * 8);
#define PG8_SA(b, h) (((b) * 2 + (h)) * HTB)
#define PG8_SB(b, h) ((4 + (b) * 2 + (h)) * HTB)
#define PG8_STAGE(bufoff, gbase, voff) do { _Pragma("unroll") for (int _i = 0; _i < 2; ++_i) \
        __builtin_amdgcn_global_load_lds((const unsigned*)((const char*)(gbase) + (voff)[_i]), (PG8_LAS unsigned*)(lds + (bufoff) + ldsw + _i * 8192), 16, 0, 0); } while (0)
#define PG8_LDA(dst, b, h) do { _Pragma("unroll") for (int m = 0; m < 4; ++m) _Pragma("unroll") for (int k = 0; k < 2; ++k) dst[m][k] = *(const PG8_LAS bf16x8*)(lds + PG8_SA(b, h) + aoff + m * 2048 + k * 1024); } while (0)
#define PG8_LDB(dst, b, h) do { _Pragma("unroll") for (int n = 0; n < 2; ++n) _Pragma("unroll") for (int k = 0; k < 2; ++k) dst[n][k] = *(const PG8_LAS bf16x8*)(lds + PG8_SB(b, h) + boff + n * 2048 + k * 1024); } while (0)
#define PG8_MMA(ai, bj, At, Bt) do { __builtin_amdgcn_s_setprio(1); _Pragma("unroll") for (int m = 0; m < 4; ++m) _Pragma("unroll") for (int n = 0; n < 2; ++n) _Pragma("unroll") for (int k = 0; k < 2; ++k) \
        acc[ai][bj][m][n] = __builtin_amdgcn_mfma_f32_16x16x32_bf16(Bt[n][k], At[m][k], acc[ai][bj][m][n], 0, 0, 0); __builtin_amdgcn_s_setprio(0); } while (0)
#define PG8_WAIT_V(n) asm volatile("s_waitcnt vmcnt(" #n ")" ::: "memory")
#define PG8_WAIT_L(n) asm volatile("s_waitcnt lgkmcnt(" #n ")" ::: "memory")
#define PG8_BAR __builtin_amdgcn_s_barrier()
#define PG8_SCHED __builtin_amdgcn_sched_barrier(0)
    Unit cur, nxt; int ui = 0;
    if (!S.next(0, cur)) return;
    f32x4 acc[2][2][4][2]; float zf_ = 0.f; asm volatile("" : "+v"(zf_));
#pragma unroll
    for (int a = 0; a < 2; ++a)
#pragma unroll
        for (int b = 0; b < 2; ++b)
#pragma unroll
            for (int m = 0; m < 4; ++m)
#pragma unroll
                for (int n = 0; n < 2; ++n) acc[a][b][m][n] = (f32x4){zf_, zf_, zf_, zf_};
    bf16x8 At[4][2], B0[2][2], B1[2][2];
    const char* cA = (const char*)g.A + (size_t)arow(cur.pm) * K * 2; const char* cB = (const char*)g.Bt + (size_t)cur.pn * tstep;
    S.a_ready(cur);
    if constexpr (SP2) {
        PG8_STAGE(PG8_SB(0, 0), cB, voffB); PG8_STAGE(PG8_SB(0, 1), cB + hstep, voffB); PG8_STAGE(PG8_SA(0, 0), cA, voffA); PG8_STAGE(PG8_SA(0, 1), cA + hstep, voffA);
        if (wr == 1) PG8_BAR;
        PG8_WAIT_V(2); PG8_BAR;
        PG8_STAGE(PG8_SB(1, 0), cB + kstep, voffB); PG8_STAGE(PG8_SA(1, 0), cA + kstep, voffA); PG8_STAGE(PG8_SB(1, 1), cB + hstep + kstep, voffB);
        PG8_WAIT_V(6); PG8_BAR;
    } else {
        PG8_STAGE(PG8_SB(0, 0), cB, voffB); PG8_STAGE(PG8_SA(0, 0), cA, voffA); PG8_STAGE(PG8_SB(0, 1), cB + hstep, voffB); PG8_STAGE(PG8_SA(0, 1), cA + hstep, voffA);
        if (wr == 1) PG8_BAR;
        PG8_WAIT_V(4); PG8_BAR;
        PG8_STAGE(PG8_SB(1, 0), cB + kstep, voffB); PG8_STAGE(PG8_SA(1, 0), cA + kstep, voffA); PG8_STAGE(PG8_SB(1, 1), cB + hstep + kstep, voffB);
        PG8_WAIT_V(6); PG8_BAR;
    }
    for (;;) {
        const bool has_next = S.next(ui + 1, nxt);
        const char* nA = has_next ? (const char*)g.A + (size_t)arow(nxt.pm) * K * 2 : cA; const char* nB = has_next ? (const char*)g.Bt + (size_t)nxt.pn * tstep : cB;
        for (int t = 0; t < nt; t += 2) {
            const bool last = (t == nt - 2);
            const char* a1 = cA + (size_t)(t + 1) * kstep;
            const char* a2 = last ? nA : cA + (size_t)(t + 2) * kstep; const char* b2 = last ? nB : cB + (size_t)(t + 2) * kstep;
            const char* a3 = a2 + kstep; const char* b3 = b2 + kstep;
            if (last && has_next) S.a_ready(nxt);
            if constexpr (SP2) {
            PG8_LDB(B0, 0, 0); PG8_LDB(B1, 0, 1); PG8_SCHED; PG8_LDA(At, 0, 0); PG8_STAGE(PG8_SA(1, 1), a1 + hstep, voffA);
            PG8_WAIT_V(8); PG8_WAIT_L(0); PG8_BAR; PG8_MMA(0, 0, At, B0); PG8_MMA(0, 1, At, B1); PG8_BAR; PG8_SCHED;
            PG8_LDA(At, 0, 1); PG8_STAGE(PG8_SB(0, 0), b2, voffB); PG8_STAGE(PG8_SB(0, 1), b2 + hstep, voffB); PG8_STAGE(PG8_SA(0, 0), a2, voffA);
            PG8_WAIT_V(8); PG8_WAIT_L(0); PG8_BAR; PG8_MMA(1, 0, At, B0); PG8_MMA(1, 1, At, B1); PG8_BAR; PG8_SCHED;
            PG8_LDB(B0, 1, 0); PG8_LDB(B1, 1, 1); PG8_SCHED; PG8_LDA(At, 1, 0); PG8_STAGE(PG8_SA(0, 1), a2 + hstep, voffA);
            PG8_WAIT_V(8); PG8_WAIT_L(0); PG8_BAR; PG8_MMA(0, 0, At, B0); PG8_MMA(0, 1, At, B1); PG8_BAR; PG8_SCHED;
            PG8_LDA(At, 1, 1); PG8_STAGE(PG8_SB(1, 0), b3, voffB); PG8_STAGE(PG8_SB(1, 1), b3 + hstep, voffB); PG8_STAGE(PG8_SA(1, 0), a3, voffA);
            PG8_WAIT_V(8); PG8_WAIT_L(0); PG8_BAR; PG8_MMA(1, 0, At, B0); PG8_MMA(1, 1, At, B1); PG8_BAR; PG8_SCHED;
            } else {
            PG8_LDB(B0, 0, 0); PG8_SCHED; PG8_LDA(At, 0, 0); PG8_STAGE(PG8_SA(1, 1), a1 + hstep, voffA);
            PG8_WAIT_L(8); PG8_BAR; PG8_WAIT_L(0); PG8_MMA(0, 0, At, B0); PG8_BAR; PG8_SCHED;
            PG8_LDB(B1, 0, 1); PG8_STAGE(PG8_SB(0, 0), b2, voffB);
            PG8_BAR; PG8_WAIT_L(0); PG8_MMA(0, 1, At, B1); PG8_BAR;
            PG8_LDA(At, 0, 1); PG8_STAGE(PG8_SA(0, 0), a2, voffA);
            PG8_BAR; PG8_WAIT_L(0); PG8_MMA(1, 0, At, B0); PG8_BAR; PG8_SCHED;
            PG8_STAGE(PG8_SB(0, 1), b2 + hstep, voffB);
            PG8_WAIT_V(6); PG8_BAR; PG8_MMA(1, 1, At, B1); PG8_BAR;
            PG8_LDB(B0, 1, 0); PG8_SCHED; PG8_LDA(At, 1, 0); PG8_STAGE(PG8_SA(0, 1), a2 + hstep, voffA);
            PG8_WAIT_L(8); PG8_BAR; PG8_WAIT_L(0); PG8_MMA(0, 0, At, B0); PG8_BAR; PG8_SCHED;
            PG8_LDB(B1, 1, 1); PG8_STAGE(PG8_SB(1, 0), b3, voffB);
            PG8_BAR; PG8_WAIT_L(0); PG8_MMA(0, 1, At, B1); PG8_BAR;
            PG8_LDA(At, 1, 1); PG8_STAGE(PG8_SA(1, 0), a3, voffA);
            PG8_BAR; PG8_WAIT_L(0); PG8_MMA(1, 0, At, B0); PG8_BAR; PG8_SCHED;
            PG8_STAGE(PG8_SB(1, 1), b3 + hstep, voffB);
            PG8_WAIT_V(6); PG8_BAR; PG8_MMA(1, 1, At, B1); PG8_BAR;
            }
        }
        if constexpr (ALIGN_EPI) { if (wr == 0) PG8_BAR; }
        if constexpr (!Epi::AFTER_DRAIN) { E(acc, cur, wr, wc, fr, fq); S.done(cur); }
        if (!has_next) break;
#pragma unroll
        for (int a = 0; a < 2; ++a)
#pragma unroll
            for (int b = 0; b < 2; ++b)
#pragma unroll
                for (int m = 0; m < 4; ++m)
#pragma unroll
                    for (int n = 0; n < 2; ++n) acc[a][b][m][n] = (f32x4){zf_, zf_, zf_, zf_};
        cur = nxt; cA = nA; cB = nB; ++ui;
        if constexpr (ALIGN_EPI) { if (wr == 1) PG8_BAR; }
    }
    PG8_WAIT_V(0);
    if constexpr (!ALIGN_EPI) { if (wr == 0) PG8_BAR; }
    PG8_BAR;
    if constexpr (Epi::AFTER_DRAIN) { E.fused(acc, cur, wr, wc, fr, fq, lds, wid, lane); S.done(cur); }
#undef PG8_SA
#undef PG8_SB
#undef PG8_STAGE
#undef PG8_LDA
#undef PG8_LDB
#undef PG8_MMA
#undef PG8_WAIT_V
#undef PG8_WAIT_L
#undef PG8_BAR
#undef PG8_SCHED
}
}

namespace attn_body {
using bf16=__hip_bfloat16;
using bf16x8=__attribute__((ext_vector_type(8)))short;
using s16x4=__attribute__((ext_vector_type(4)))short;
using f32x16=__attribute__((ext_vector_type(16)))float;
using u32x4=__attribute__((ext_vector_type(4)))unsigned;
constexpr int SEQ=16640,TREAL=16400,D=64,DM=1024;
constexpr int NW=8,QBLK=32,QB=QBLK*NW,KVBLK=64,NQB=SEQ/QB;
constexpr int ATTN_PITCH=DM, ATTN_UNIT_ROWS=QB;
__device__ __forceinline__ int crow(int r,int hi){return (r&3)+8*(r>>2)+4*hi;}
#define SBAR() __builtin_amdgcn_sched_barrier(0)
typedef unsigned u32x2 __attribute__((ext_vector_type(2)));
__device__ __forceinline__ void mmask(f32x16&p0,f32x16&p1,unsigned w0,unsigned w1,int hi,float nmh){
  const float NEG=-INFINITY; const unsigned a=w0>>(4*hi), b=w1>>(4*hi);
  #pragma unroll
  for(int r=0;r<16;++r){const int c=(r&3)+8*(r>>2); p0[r]=((a>>c)&1u)?p0[r]+nmh:NEG; p1[r]=((b>>c)&1u)?p1[r]+nmh:NEG;}
}
__device__ __forceinline__ void cmask(f32x16&p0,f32x16&p1,int jb,int qrel,int hi){
  const float NEG=-INFINITY; int kb=64*jb+4*hi;
  #pragma unroll
  for(int r=0;r<16;++r){int kv=kb+(r&3)+8*(r>>2); if(kv>qrel)p0[r]=NEG; if(kv+32>qrel)p1[r]=NEG;}
}

constexpr int NSLOT=3, SLOTB=8192;
constexpr int VSLOTB=2*SLOTB;
constexpr int LDS_K=0, LDS_V=NSLOT*SLOTB, LDS_WS=LDS_V+NSLOT*VSLOTB, LDS_OST=LDS_WS+NW*64*4, LDS_MK=LDS_OST+NW*4096, LDS_BYTES=LDS_MK+NW*2048;
constexpr float C2=0.125f*1.4426950408889634f;
__device__ __forceinline__ void glds16(const void*gsrc,unsigned lds_dst){unsigned keep;
  asm volatile("s_mov_b32 %0, m0\n\ts_mov_b32 m0, %2\n\ts_nop 0\n\tglobal_load_lds_dwordx4 %1, off\n\ts_mov_b32 m0, %0":"=&s"(keep):"v"(gsrc),"s"(lds_dst):"memory");}
__device__ __forceinline__ float max3f(float a,float b,float c){float r;asm("v_max3_f32 %0, %1, %2, %3":"=v"(r):"v"(a),"v"(b),"v"(c));return r;}
__device__ __forceinline__ float max2f(float a,float b){float r;asm("v_max_f32_e32 %0, %1, %2":"=v"(r):"v"(a),"v"(b));return r;}
__device__ __forceinline__ float fadd_s(float a,float b){float r;asm("v_add_f32_e32 %0, %1, %2":"=v"(r):"v"(a),"v"(b));return r;}
__device__ __forceinline__ float fsub_s(float a,float b){float r;asm("v_sub_f32_e32 %0, %1, %2":"=v"(r):"v"(a),"v"(b));return r;}
typedef float f32x2_t __attribute__((ext_vector_type(2))); typedef __bf16 bf16x2_t __attribute__((ext_vector_type(2)));
__device__ __forceinline__ unsigned cvtpk_s(float lo,float hi){f32x2_t v={lo,hi};bf16x2_t b=__builtin_convertvector(v,bf16x2_t);return __builtin_bit_cast(unsigned,b);}
#define WAIT_BAR(N) asm volatile("s_waitcnt vmcnt(" #N ") lgkmcnt(0)\n\ts_barrier":::"memory")

__device__ __forceinline__ void qkt(f32x16&p0,f32x16&p1,const char*Kslot,const bf16x8*qr,const f32x16&negm,int r32,int hi){
  const char*kb=Kslot+hi*1024+r32*16;
  #pragma unroll
  for(int d0=0;d0<4;++d0){
    const bf16x8 b0=*reinterpret_cast<const bf16x8*>(kb+d0*2048);
    const bf16x8 b1=*reinterpret_cast<const bf16x8*>(kb+d0*2048+512);
    if(d0==0){p0=__builtin_amdgcn_mfma_f32_32x32x16_bf16(b0,qr[0],negm,0,0,0);p1=__builtin_amdgcn_mfma_f32_32x32x16_bf16(b1,qr[0],negm,0,0,0);}
    else{p0=__builtin_amdgcn_mfma_f32_32x32x16_bf16(b0,qr[d0],p0,0,0,0);p1=__builtin_amdgcn_mfma_f32_32x32x16_bf16(b1,qr[d0],p1,0,0,0);}}
}
typedef __attribute__((address_space(3))) const char* lds_cptr;
typedef short v4i16_t __attribute__((ext_vector_type(4)));
__device__ __forceinline__ void kload8(bf16x8*kf,lds_cptr kp){
  kf[0]=*(const __attribute__((address_space(3))) bf16x8*)(kp);      kf[1]=*(const __attribute__((address_space(3))) bf16x8*)(kp+512);
  kf[2]=*(const __attribute__((address_space(3))) bf16x8*)(kp+2048); kf[3]=*(const __attribute__((address_space(3))) bf16x8*)(kp+2560);
  kf[4]=*(const __attribute__((address_space(3))) bf16x8*)(kp+4096); kf[5]=*(const __attribute__((address_space(3))) bf16x8*)(kp+4608);
  kf[6]=*(const __attribute__((address_space(3))) bf16x8*)(kp+6144); kf[7]=*(const __attribute__((address_space(3))) bf16x8*)(kp+6656);
}
__device__ __forceinline__ void kload2(bf16x8*kf,lds_cptr kp,int j){ kf[2*j]=*(const __attribute__((address_space(3))) bf16x8*)(kp+j*2048); kf[2*j+1]=*(const __attribute__((address_space(3))) bf16x8*)(kp+j*2048+512); }
__device__ __forceinline__ s16x4 vtr(lds_cptr p){ return __builtin_bit_cast(s16x4,__builtin_amdgcn_ds_read_tr16_b64_v4i16((__attribute__((address_space(3))) v4i16_t*)p)); }
__device__ __forceinline__ float rowmax(const f32x16&p0,const f32x16&p1){
  float a=max3f(p0[0],p0[1],p1[0]),b=max3f(p0[2],p0[3],p1[1]);a=max3f(a,p1[2],p1[3]);
  #pragma unroll
  for(int r=4;r<16;r+=4){a=max3f(a,p0[r],p0[r+1]);b=max3f(b,p0[r+2],p0[r+3]);a=max3f(a,p1[r],p1[r+1]);b=max3f(b,p1[r+2],p1[r+3]);}
  const float m=max2f(a,b);
  auto rr=__builtin_amdgcn_permlane32_swap(__float_as_uint(m),__float_as_uint(m),false,false);
  return max2f(__uint_as_float(rr[0]),__uint_as_float(rr[1]));
}
__device__ __forceinline__ void pv(f32x16*o,int vb,bf16x8 pa0,bf16x8 pa1,bf16x8 pa2,bf16x8 pa3){
  #pragma unroll
  for(int d0=0;d0<2;++d0){s16x4 lo[4],hi[4];
    #pragma unroll
    for(int ks=0;ks<4;++ks){
      asm volatile("ds_read_b64_tr_b16 %0,%1 offset:%c2":"=&v"(lo[ks]):"v"(vb),"i"(d0*4096+ks*1024):"memory");
      asm volatile("ds_read_b64_tr_b16 %0,%1 offset:%c2":"=&v"(hi[ks]):"v"(vb),"i"(d0*4096+ks*1024+512):"memory");}
    asm volatile("s_waitcnt lgkmcnt(0)":::"memory");SBAR();
    #define PK(k) (bf16x8){lo[k][0],lo[k][1],lo[k][2],lo[k][3],hi[k][0],hi[k][1],hi[k][2],hi[k][3]}
    o[d0]=__builtin_amdgcn_mfma_f32_32x32x16_bf16(pa0,PK(0),o[d0],0,0,0);
    o[d0]=__builtin_amdgcn_mfma_f32_32x32x16_bf16(pa1,PK(1),o[d0],0,0,0);
    o[d0]=__builtin_amdgcn_mfma_f32_32x32x16_bf16(pa2,PK(2),o[d0],0,0,0);
    o[d0]=__builtin_amdgcn_mfma_f32_32x32x16_bf16(pa3,PK(3),o[d0],0,0,0);
    #undef PK
  }
}

#ifndef ATTN_STORE16
#define ATTN_STORE16(p,v) (*(u32x4*)(p)=(v))
#endif
template<int THRL,bool MASKED,int VW> __device__ __forceinline__ void attn_unit(int b,int hq,int hv,int qb,const bf16*Q,const bf16*__restrict__ K,const bf16*__restrict__ V,bf16*O,const unsigned*__restrict__ MK,char*shm,const int wv_){
  int tid_=wv_*64+lane_id(); asm volatile("":"+v"(tid_));
  const int tid=tid_,lane=tid&63,r32=lane&31,hi=lane>>5; const int wid=__builtin_amdgcn_readfirstlane(tid>>6);
  const long rowbase=(long)b*SEQ; const int q0=qb*QB;
  const bf16*Qw=Q+(rowbase+q0+wid*QBLK)*DM+hq*D;
  const bf16*Kh=K+rowbase*DM+hq*D,*Vh=V+rowbase*DM+hv*D;
  const unsigned lds0=(unsigned)(uintptr_t)shm;
  float*wsf=(float*)(shm+LDS_WS)+wid*64;
  const bf16*ksrc=Kh+(long)lane*DM+wid*8;
  const bf16*vsrc=Vh+(long)(16*(wid&3)+(lane>>2))*DM+(wid>>2)*32+(lane&3)*8;
  const unsigned kdst=lds0+LDS_K+wid*1024, vdst=lds0+LDS_V+wid*1024;
  #define DMA_K(t,slot) glds16(ksrc+(long)(t)*KVBLK*DM,(unsigned)__builtin_amdgcn_readfirstlane(kdst+(slot)))
  #define DMA_V(t,slot) do{ glds16(vsrc+(long)(t)*KVBLK*DM,(unsigned)__builtin_amdgcn_readfirstlane(vdst+2*(slot))); if(VW==2){glds16(vsrc+64+(long)(t)*KVBLK*DM,(unsigned)__builtin_amdgcn_readfirstlane(vdst+8192+2*(slot)));} }while(0)
  const int vb0=(int)(lds0+LDS_V)+((lane>>4)&1)*32+(lane&3)*8+(4*hi+((lane&15)>>2))*64;
  const char*Kbase=shm+LDS_K; bf16x8 kf[8];
  const lds_cptr shm3=(lds_cptr)shm; const lds_cptr kp0=shm3+LDS_K+hi*1024+r32*16; const lds_cptr vp0=shm3+LDS_V+((lane>>4)&1)*32+(lane&3)*8+(4*hi+((lane&15)>>2))*64;
  const int NT=(q0+QB)/KVBLK;
  constexpr bool NEGM_=VW==1;
  const unsigned*msrc=MK+((rowbase+q0+wid*QBLK+r32)*520+4*hi); const unsigned mdst=lds0+LDS_MK+wid*2048; const lds_cptr mp0=(lds_cptr)shm+LDS_MK+wid*2048+r32*16;
  #define DMA_M(j) glds16(msrc+8*(j),(unsigned)__builtin_amdgcn_readfirstlane(mdst+(((j)&1)*1024)))
  unsigned mka_=0u,mkb_=0u;
  #define MMASK(P0,P1,t) do{ if(MASKED){ const u32x2 mw_=*(const __attribute__((address_space(3))) u32x2*)(mp0+((((t)>>2)&1)*1024+(((t)>>1)&1)*512+((t)&1)*8)); mka_=mw_.x>>(4*hi); mkb_=mw_.y>>(4*hi);} }while(0)
  #define MSEL(X,r,MK) do{ if(MASKED){ X[r]=__uint_as_float(__float_as_uint(X[r])&(unsigned)__builtin_amdgcn_sbfe((int)(MK),((r)&3)+8*((r)>>2),1)); } }while(0)
  if(MASKED){DMA_M(0);}
  DMA_K(0,0);DMA_V(0,0);DMA_K(1,SLOTB);
  bf16x8 qr[4];
  #pragma unroll
  for(int d0=0;d0<4;++d0)qr[d0]=*reinterpret_cast<const bf16x8*>(&Qw[(long)r32*DM+d0*16+hi*8]);
  constexpr bool QLDS=VW==2||MASKED;
  const lds_cptr qst=(lds_cptr)shm+LDS_OST+wid*4096+lane*16;
  if(QLDS){ _Pragma("unroll") for(int d0=0;d0<4;++d0) *(__attribute__((address_space(3))) bf16x8*)((__attribute__((address_space(3))) char*)(qst+d0*1024))=qr[d0]; }
  #define QF(d0) (QLDS?*(const __attribute__((address_space(3))) bf16x8*)(qst+(d0)*1024):qr[d0])
  float mhat=0.f,l_reg=0.f;constexpr bool NEGM=VW==1;
  float zf_=0.f; asm volatile("":"+v"(zf_)); const f32x16 zv_={zf_,zf_,zf_,zf_,zf_,zf_,zf_,zf_,zf_,zf_,zf_,zf_,zf_,zf_,zf_,zf_};
  f32x16 o[2*VW];_Pragma("unroll") for(int i_=0;i_<2*VW;++i_)o[i_]=zv_;f32x16 negm=zv_;if(NEGM){asm volatile("":"+v"(negm));}
  const int qrel=wid*QBLK+r32;
  #define CMASK(P0,P1,t) do{ if(!MASKED){int jb_=(t)-(NT-4); if(jb_>=0)cmask(P0,P1,jb_,qrel,hi);} MMASK(P0,P1,t); }while(0)
  bool resc=false;
  #define START(P0,P1) do{ const float rm=rowmax(P0,P1); resc=false; \
    { const float dl=(VW==2&&__builtin_fabsf(rm)<=(float)THRL)?0.f:rm;     \
      mhat=fadd_s(mhat,dl); \
      _Pragma("unroll") for(int r=0;r<16;++r){P0[r]=fsub_s(P0[r],dl);P1[r]=fsub_s(P1[r],dl);} \
      if(NEGM){_Pragma("unroll") for(int r=0;r<16;++r)negm[r]=-mhat; asm volatile("":"+v"(negm));} } \
    _Pragma("unroll") for(int r=0;r<16;++r){P0[r]=__builtin_amdgcn_exp2f(P0[r]); MSEL(P0,r,mka_);} }while(0)
  #define RESC() do{ if(resc){ asm volatile("s_waitcnt lgkmcnt(0)":::"memory"); \
      _Pragma("unroll") for(int d_=0;d_<2*VW;++d_) _Pragma("unroll") for(int r=0;r<16;++r)o[d_][r]*=wsf[crow(r,hi)]; } }while(0)
  f32x16 pA0,pA1,pB0,pB1;
  int sl_prev=0,sl_cur=0,sl_next=SLOTB;
  #define ROT() do{sl_prev=sl_cur;sl_cur=sl_next;sl_next=(sl_next==(NSLOT-1)*SLOTB)?0:sl_next+SLOTB;}while(0)
  DMA_K(2,2*SLOTB);
  WAIT_BAR(3);
  qkt(pA0,pA1,Kbase,qr,negm,r32,hi);asm volatile("s_nop 15\n\ts_nop 7":"+v"(pA0),"+v"(pA1));CMASK(pA0,pA1,0);
  START(pA0,pA1);
  _Pragma("unroll") for(int r=0;r<16;++r){pA1[r]=__builtin_amdgcn_exp2f(pA1[r]); MSEL(pA1,r,mkb_);}
  WAIT_BAR(0);
  DMA_K(3,0);DMA_V(1,SLOTB);
  ROT();
  kload8(kf,kp0+sl_cur);
  if(VW==2){WAIT_BAR(3);}else{WAIT_BAR(2);}
  s16x4 vlo[8],vhi[8]; u32x4 pw0,pw1,pw2,pw3;
  #define PKW(P,B) cvtpk_s(P[B],P[B+1])
  #define PAF(k) __builtin_bit_cast(bf16x8,pw##k)
  #define VFR(i) (bf16x8){vlo[i][0],vlo[i][1],vlo[i][2],vlo[i][3],vhi[i][0],vhi[i][1],vhi[i][2],vhi[i][3]}
  #define PIN(x) asm volatile("":"+v"(x))
  #define MX3(a,b,c) __builtin_fmaxf(__builtin_fmaxf((a),(b)),(c))
  #define GAPA(MF,A0,A1,A2,A3,W0,W1,PW) do{ MF; sacc+=A0; sacc+=A1; sacc+=A2; sacc+=A3; PIN(sacc); W0; W1; PIN(PW); SBAR(); }while(0)
  #define EX(v) __builtin_amdgcn_exp2f(v)
  #define GAPB(MF,X,B) do{ MF; X[B]=EX(X[B]); X[B+1]=EX(X[B+1]); X[B+2]=EX(X[B+2]); X[B+3]=EX(X[B+3]); PIN(X); SBAR(); }while(0)
  #define VRD(i) do{ vlo[i]=vtr(vp_+(((i)>>2)*4096+((i)&3)*1024)); vhi[i]=vtr(vp_+(((i)>>2)*4096+((i)&3)*1024+512)); }while(0)
  #define KRD(G,j) do{ if(G){ kload2(kf,kp0+sl_next,j); SBAR(); } }while(0)
  #define VRD2(i) do{ if(VW==2){ vlo[i]=vtr(vp_+(8192+((i)>>2)*4096+((i)&3)*1024)); vhi[i]=vtr(vp_+(8192+((i)>>2)*4096+((i)&3)*1024+512)); } }while(0)
  #define GAPB2(MF,X,B,VI,MK) do{ MF; VRD2(VI); X[B]=EX(X[B]); X[B+1]=EX(X[B+1]); X[B+2]=EX(X[B+2]); X[B+3]=EX(X[B+3]); MSEL(X,B,MK); MSEL(X,B+1,MK); MSEL(X,B+2,MK); MSEL(X,B+3,MK); PIN(X); SBAR(); }while(0)
  const f32x16 zero16_=f32x16{};
  #define CIN (NEGM?negm:zero16_)
  #define STEP(C0,C1,P0,P1,t,GK,GV,GL) do{ SBAR(); \
    const lds_cptr vp_=vp0+2*sl_prev; bf16x8 qt_; \
    VRD(0); SBAR(); float sacc=(P0[0]+P0[1]); \
    GAPA(C0=__builtin_amdgcn_mfma_f32_32x32x16_bf16(kf[0],(qt_=QF(0)),CIN,0,0,0), P0[2],P0[3],P0[4],P0[5],     pw0[0]=PKW(P0,0), pw0[1]=PKW(P0,2), pw0); \
    VRD(4); SBAR(); GAPA(C1=__builtin_amdgcn_mfma_f32_32x32x16_bf16(kf[1],qt_,CIN,0,0,0), P0[6],P0[7],P0[8],P0[9],     pw0[2]=PKW(P0,4), pw0[3]=PKW(P0,6), pw0); \
    VRD(1); SBAR(); GAPA(C0=__builtin_amdgcn_mfma_f32_32x32x16_bf16(kf[2],(qt_=QF(1)),C0,0,0,0),   P0[10],P0[11],P0[12],P0[13], pw1[0]=PKW(P0,8), pw1[1]=PKW(P0,10), pw1); \
    VRD(5); SBAR(); GAPA(C1=__builtin_amdgcn_mfma_f32_32x32x16_bf16(kf[3],qt_,C1,0,0,0),   P0[14],P0[15],P1[0],P1[1],   pw1[2]=PKW(P0,12),pw1[3]=PKW(P0,14), pw1); \
    VRD(2); SBAR(); GAPA(C0=__builtin_amdgcn_mfma_f32_32x32x16_bf16(kf[4],(qt_=QF(2)),C0,0,0,0),   P1[2],P1[3],P1[4],P1[5],     pw2[0]=PKW(P1,0), pw2[1]=PKW(P1,2), pw2); \
    VRD(6); SBAR(); GAPA(C1=__builtin_amdgcn_mfma_f32_32x32x16_bf16(kf[5],qt_,C1,0,0,0),   P1[6],P1[7],P1[8],P1[9],     pw2[2]=PKW(P1,4), pw2[3]=PKW(P1,6), pw2); \
    VRD(3); SBAR(); GAPA(C0=__builtin_amdgcn_mfma_f32_32x32x16_bf16(kf[6],(qt_=QF(3)),C0,0,0,0),   P1[10],P1[11],P1[12],P1[13], pw3[0]=PKW(P1,8), pw3[1]=PKW(P1,10), pw3); \
    VRD(7); SBAR(); GAPA(C1=__builtin_amdgcn_mfma_f32_32x32x16_bf16(kf[7],qt_,C1,0,0,0),   P1[14],P1[15],0.f,0.f,       pw3[2]=PKW(P1,12),pw3[3]=PKW(P1,14), pw3); \
    l_reg+=sacc; \
    if(MASKED&&(((t)&3)==2)&&((t)+2<NT)){DMA_M(((t)+2)>>2);} if(GK){DMA_K((t)+3,sl_cur);} if(GV){DMA_V((t)+1,sl_next);} \
    CMASK(C0,C1,t); \
    if(!NEGM&&!MASKED){ if(__any(mhat!=0.f)){ _Pragma("unroll") for(int r=0;r<16;++r){C0[r]-=mhat;C1[r]-=mhat;} } } \
    { float a=MX3(C0[0],C0[1],C1[0]),b=MX3(C0[2],C0[3],C1[1]); a=MX3(a,C1[2],C1[3]); \
      _Pragma("unroll") for(int r=4;r<16;r+=4){a=MX3(a,C0[r],C0[r+1]);b=MX3(b,C0[r+2],C0[r+3]);a=MX3(a,C1[r],C1[r+1]);b=MX3(b,C1[r+2],C1[r+3]);} \
      float rm=__builtin_fmaxf(a,b); { auto rr=__builtin_amdgcn_permlane32_swap(__float_as_uint(rm),__float_as_uint(rm),false,false); rm=__builtin_fmaxf(__uint_as_float(rr[0]),__uint_as_float(rr[1])); } \
      resc=false; \
      if(__builtin_expect(__any(rm>(float)THRL),0)){ const float dl=__builtin_fmaxf(rm,0.f); mhat+=dl; \
        _Pragma("unroll") for(int r=0;r<16;++r){C0[r]-=dl;C1[r]-=dl;} \
        if(NEGM){_Pragma("unroll") for(int r=0;r<16;++r)negm[r]=-mhat; asm volatile("":"+v"(negm));} \
        const float f=__builtin_amdgcn_exp2f(-dl); l_reg*=f; if(hi==0)wsf[r32]=f; resc=true; } } \
    SBAR(); \
    GAPB2(o[0]=__builtin_amdgcn_mfma_f32_32x32x16_bf16(PAF(0),VFR(0),o[0],0,0,0), C0,0, 0,mka_); \
    GAPB2(o[1]=__builtin_amdgcn_mfma_f32_32x32x16_bf16(PAF(0),VFR(4),o[1],0,0,0), C0,4, 4,mka_); \
    KRD(GL,0); GAPB2(o[0]=__builtin_amdgcn_mfma_f32_32x32x16_bf16(PAF(1),VFR(1),o[0],0,0,0), C0,8, 1,mka_); \
    KRD(GL,1); GAPB2(o[1]=__builtin_amdgcn_mfma_f32_32x32x16_bf16(PAF(1),VFR(5),o[1],0,0,0), C0,12, 5,mka_); \
    KRD(GL,2); GAPB2(o[0]=__builtin_amdgcn_mfma_f32_32x32x16_bf16(PAF(2),VFR(2),o[0],0,0,0), C1,0, 2,mkb_); \
    KRD(GL,3); GAPB2(o[1]=__builtin_amdgcn_mfma_f32_32x32x16_bf16(PAF(2),VFR(6),o[1],0,0,0), C1,4, 6,mkb_); \
    GAPB2(o[0]=__builtin_amdgcn_mfma_f32_32x32x16_bf16(PAF(3),VFR(3),o[0],0,0,0), C1,8, 3,mkb_); \
    GAPB2(o[1]=__builtin_amdgcn_mfma_f32_32x32x16_bf16(PAF(3),VFR(7),o[1],0,0,0), C1,12, 7,mkb_); \
    if(VW==2){   \
      o[2*VW-2]=__builtin_amdgcn_mfma_f32_32x32x16_bf16(PAF(0),VFR(0),o[2*VW-2],0,0,0); o[2*VW-1]=__builtin_amdgcn_mfma_f32_32x32x16_bf16(PAF(0),VFR(4),o[2*VW-1],0,0,0); \
      o[2*VW-2]=__builtin_amdgcn_mfma_f32_32x32x16_bf16(PAF(1),VFR(1),o[2*VW-2],0,0,0); o[2*VW-1]=__builtin_amdgcn_mfma_f32_32x32x16_bf16(PAF(1),VFR(5),o[2*VW-1],0,0,0); \
      o[2*VW-2]=__builtin_amdgcn_mfma_f32_32x32x16_bf16(PAF(2),VFR(2),o[2*VW-2],0,0,0); o[2*VW-1]=__builtin_amdgcn_mfma_f32_32x32x16_bf16(PAF(2),VFR(6),o[2*VW-1],0,0,0); \
      o[2*VW-2]=__builtin_amdgcn_mfma_f32_32x32x16_bf16(PAF(3),VFR(3),o[2*VW-2],0,0,0); o[2*VW-1]=__builtin_amdgcn_mfma_f32_32x32x16_bf16(PAF(3),VFR(7),o[2*VW-1],0,0,0); SBAR(); } \
    }while(0)
  int t=1;
  #undef CMASK
  #define CMASK(P0,P1,t) MMASK(P0,P1,t)
  for(;t+5<NT;t+=2){
    STEP(pB0,pB1,pA0,pA1,t,true,true,true);     if(VW==2){WAIT_BAR(3);}else{WAIT_BAR(2);} RESC(); ROT();
    STEP(pA0,pA1,pB0,pB1,t+1,true,true,true);   if(VW==2){WAIT_BAR(3);}else{WAIT_BAR(2);} RESC(); ROT();
  }
  #undef CMASK
  #define CMASK(P0,P1,t) do{ if(!MASKED){int jb_=(t)-(NT-4); if(jb_>=0)cmask(P0,P1,jb_,qrel,hi);} MMASK(P0,P1,t); }while(0)
  #define ENDW(tt) do{ if((tt)+3<NT){ if(VW==2){WAIT_BAR(3);}else{WAIT_BAR(2);} } else if((tt)+2<NT){ if(VW==2){WAIT_BAR(2);}else{WAIT_BAR(1);} } else {WAIT_BAR(0);} }while(0)
  for(;t+1<NT;t+=2){
    STEP(pB0,pB1,pA0,pA1,t,(t+3<NT),(t+1<NT),(t+1<NT));       ENDW(t);   RESC(); ROT();
    STEP(pA0,pA1,pB0,pB1,t+1,(t+4<NT),(t+2<NT),(t+2<NT));     ENDW(t+1); RESC(); ROT();
  }
  STEP(pB0,pB1,pA0,pA1,NT-1,false,false,false); RESC();
  { float sacc=pB0[0]+pB0[1]; _Pragma("unroll") for(int r=2;r<16;++r)sacc+=pB0[r]; _Pragma("unroll") for(int r=0;r<16;++r)sacc+=pB1[r]; l_reg+=sacc;
    pw0=(u32x4){PKW(pB0,0),PKW(pB0,2),PKW(pB0,4),PKW(pB0,6)};pw1=(u32x4){PKW(pB0,8),PKW(pB0,10),PKW(pB0,12),PKW(pB0,14)};pw2=(u32x4){PKW(pB1,0),PKW(pB1,2),PKW(pB1,4),PKW(pB1,6)};pw3=(u32x4){PKW(pB1,8),PKW(pB1,10),PKW(pB1,12),PKW(pB1,14)};
    SBAR(); pv(o,vb0+2*sl_cur,PAF(0),PAF(1),PAF(2),PAF(3)); if(VW==2){pv(o+2*VW-2,vb0+2*sl_cur+8192,PAF(0),PAF(1),PAF(2),PAF(3));} }
  #undef PKW
  #undef PAF
  #undef VFR
  #undef PIN
  #undef MX3
  #undef GAPA
  #undef GAPB
  #undef EX
  #undef VRD
  #undef KRD
  #undef QF
  #undef VRD2
  #undef GAPB2
  #undef STEP
  #undef ENDW
  {auto rr=__builtin_amdgcn_permlane32_swap(__float_as_uint(l_reg),__float_as_uint(l_reg),false,false);l_reg=__uint_as_float(rr[0])+__uint_as_float(rr[1]);}
  if(hi==0)wsf[32+r32]=l_reg;asm volatile("s_waitcnt lgkmcnt(0)":::"memory");
  float rli[16];
  #pragma unroll
  for(int r=0;r<16;++r)rli[r]=__builtin_amdgcn_rcpf(wsf[32+crow(r,hi)]);
  bf16*Ow=O+(rowbase+q0+wid*QBLK)*DM+hv*D;
  { bf16*stg=(bf16*)(shm+LDS_OST)+wid*2048;
    #pragma unroll
    for(int e_=0;e_<VW;++e_){
    #pragma unroll
    for(int r=0;r<16;++r){const int orow=crow(r,hi);
      #pragma unroll
      for(int d0=0;d0<2;++d0)((unsigned short*)stg)[orow*64+d0*32+r32]=(unsigned short)cvtpk_s(o[2*e_+d0][r]*rli[r],0.f);}
    asm volatile("s_waitcnt lgkmcnt(0)":::"memory");
    #pragma unroll
    for(int i=0;i<4;++i){const int row=i*8+(lane>>3),ch=lane&7; const u32x4 v=*(const u32x4*)(stg+row*64+ch*8); if(q0+wid*QBLK+row<TREAL){ATTN_STORE16(Ow+(long)row*DM+64*e_+ch*8,v);}}
    asm volatile("s_waitcnt lgkmcnt(0)":::"memory"); } }
  asm volatile("s_waitcnt lgkmcnt(0)\n\ts_barrier":::"memory");
  #undef DMA_K
  #undef DMA_V
  #undef DMA_M
  #undef MMASK
  #undef MSEL
  #undef CMASK
  #undef START
  #undef RESC
  #undef ROT
}
constexpr int ATTN_LDS_BYTES=LDS_BYTES;
#undef SBAR
#undef WAIT_BAR
}

#define GAS __attribute__((address_space(1)))
#define LAS __attribute__((address_space(3)))
typedef unsigned short bf16;
typedef unsigned v4u __attribute__((ext_vector_type(4)));
typedef float f32x4 __attribute__((ext_vector_type(4)));
typedef short bf16x8 __attribute__((ext_vector_type(8)));
typedef GAS unsigned gu32;
typedef GAS unsigned long long gu64;
#define RLX_AGENT __ATOMIC_RELAXED, __HIP_MEMORY_SCOPE_AGENT
#define LDS_WAIT() asm volatile("s_waitcnt lgkmcnt(0)" ::: "memory")
#define VM_WAIT() asm volatile("s_waitcnt vmcnt(0)" ::: "memory")
__device__ __forceinline__ unsigned long long rt() { return __builtin_amdgcn_s_memrealtime(); }
__device__ __forceinline__ unsigned f2bf(float f) { unsigned u = __builtin_bit_cast(unsigned, f); return (u + 0x7fffu + ((u >> 16) & 1u)) >> 16; }
typedef float pk2_f32x2_ __attribute__((ext_vector_type(2))); typedef __bf16 pk2_bf16x2_ __attribute__((ext_vector_type(2)));
__device__ __forceinline__ unsigned pk2(float lo, float hi) { pk2_f32x2_ v = {lo, hi}; pk2_bf16x2_ b = __builtin_convertvector(v, pk2_bf16x2_); return __builtin_bit_cast(unsigned, b); }

#define XB_TMO      128
#define XB_XCNT(j)  (256  + 64 * (j))
#define XB_XSUB(j)  (1280 + 64 * (j))
#define XB_XGEN(j)  (2304 + 64 * (j))
#define XB_TOP      3328
#define XB_TOPGEN   3392
#define XCD_BAR_WORDS 3456
#define XB_SPIN_CAP (1u << 22)

__device__ __forceinline__ unsigned xb_ld(unsigned* p)              { return __hip_atomic_load(p, __ATOMIC_RELAXED, __HIP_MEMORY_SCOPE_AGENT); }
__device__ __forceinline__ unsigned xb_add(unsigned* p, unsigned v) { return __hip_atomic_fetch_add(p, v, __ATOMIC_RELAXED, __HIP_MEMORY_SCOPE_AGENT); }
__device__ __forceinline__ unsigned xb_xcc_id() { return (unsigned)__builtin_amdgcn_s_getreg((3 << 11) | 20) & 0xFu; }
#define XB_SPIN(cond, bar) do { unsigned _sp = 0; while (cond) { __builtin_amdgcn_s_sleep(1); \
    if ((++_sp & 255u) == 0u) { if (xb_ld(&(bar)[XB_TMO])) break; if (_sp > XB_SPIN_CAP) { atomicAdd(&(bar)[XB_TMO], 1u); break; } } } } while (0)

struct XcdBarrier {
    unsigned* bar; unsigned x;
    volatile LAS unsigned* st;
};

__device__ __forceinline__ XcdBarrier xcd_barrier_post(unsigned* bar, volatile LAS unsigned* st, const int wv_) {
    XcdBarrier b; b.bar = bar; b.x = xb_xcc_id(); b.st = st;
    if (wv_ == 0 && lane_id() == 0) (void)xb_add(&bar[XB_XCNT(b.x)], 1u);
    return b;
}
__device__ __forceinline__ void xcd_barrier_complete(unsigned* bar, unsigned x, unsigned& nloc, unsigned& nx) {
    const unsigned G = gridDim.x * gridDim.y * gridDim.z;
    unsigned sum, cnt, mine, sp = 0u;
    for (;;) {
        sum = 0u; cnt = 0u; mine = 0u;
#pragma unroll
        for (unsigned j = 0; j < 16; ++j) { const unsigned c = xb_ld(&bar[XB_XCNT(j)]); sum += c; cnt += (c > 0u) ? 1u : 0u; mine = (j == x) ? c : mine; }
        if (sum == G) break;
        __builtin_amdgcn_s_sleep(1);
        if ((++sp & 255u) == 0u) { if (xb_ld(&bar[XB_TMO])) break; if (sp > XB_SPIN_CAP) { atomicAdd(&bar[XB_TMO], 1u); break; } }
    }
    nloc = mine > 0u ? mine : 1u; nx = cnt > 0u ? cnt : 1u;
}

__device__ __forceinline__ void xcd_barrier(const XcdBarrier& b, const int wv_) {
    asm volatile("s_waitcnt vmcnt(0)" ::: "memory");
    __syncthreads();
    if (wv_ == 0 && lane_id() == 0) {
        unsigned* bar = b.bar;
        __builtin_amdgcn_s_waitcnt(0);
        unsigned nloc = b.st[0], nx = b.st[1];
        if (nloc == 0u) { xcd_barrier_complete(bar, b.x, nloc, nx); b.st[0] = nloc; b.st[1] = nx; }
        const unsigned old = xb_add(&bar[XB_XSUB(b.x)], 1u);
        const unsigned gen = old / nloc;
        if (old + 1u == (gen + 1u) * nloc) {
            __builtin_amdgcn_fence(__ATOMIC_RELEASE, "agent");
            asm volatile("s_waitcnt vmcnt(0)" ::: "memory");
            const unsigned og = xb_add(&bar[XB_TOP], 1u);
            const unsigned tg = og / nx;
            if (og + 1u == (tg + 1u) * nx) xb_add(&bar[XB_TOPGEN], 1u);
            else XB_SPIN(xb_ld(&bar[XB_TOPGEN]) == tg, bar);
            __builtin_amdgcn_fence(__ATOMIC_ACQUIRE, "agent");
            xb_add(&bar[XB_XGEN(b.x)], 1u);
            asm volatile("s_waitcnt vmcnt(0)" ::: "memory");
        } else {
            XB_SPIN(xb_ld(&bar[XB_XGEN(b.x)]) == gen, bar);
            __builtin_amdgcn_fence(__ATOMIC_ACQUIRE, "agent");
            asm volatile("s_waitcnt vmcnt(0)" ::: "memory");
        }
    }
    __syncthreads();
}

typedef float f32x16 __attribute__((ext_vector_type(16)));
typedef unsigned u32x2 __attribute__((ext_vector_type(2)));
constexpr int NBATCH = 2, SEQL = 16384, DMODEL = 1024, NMETA = 16, TREAL = 16400, TALLOC = 16640, MALLOC = 2 * TALLOC;
constexpr int NWAVES = 8, MTILES = 32768;
constexpr int FFN_H = 2816;
constexpr int NIN = 3656, NIN_PAD = 3840, SIDE_W = 640, NSIDE = 584;
constexpr float RMS_EPS = 1e-6f;
constexpr float QSCALE = 0.125f * 1.4426950408889634f;
constexpr int MWORDS = 520;
constexpr int TOPK_NM = 240, TIE_CAP = 64;
constexpr float LAMBDA_INIT0 = 0.2f;

constexpr size_t MiB = 1u << 20;
constexpr size_t WS_CTL = 0, CTL_ZERO_BYTES = 1 * MiB;
constexpr size_t WS_WQKV = 2 * MiB, WS_WO1 = 8 * MiB, WS_WIN = 10 * MiB, WS_WO2 = 18 * MiB;
constexpr size_t WS_WUP = 20 * MiB  , WS_WDN = 42 * MiB  ;
constexpr size_t DO_TS = 0, DO_HL = 32 * MiB, DO_HF = 36 * MiB, DO_UM = 40 * MiB;
constexpr size_t WS_COS = 54 * MiB, WS_SIN = 57 * MiB;
constexpr size_t WS_H = 60 * MiB;
constexpr size_t WS_XN = 190 * MiB;
constexpr size_t WS_Q = 255 * MiB, WS_K = 320 * MiB, WS_V = 385 * MiB;
constexpr size_t WS_QI = 450 * MiB, WS_KI = 483 * MiB, WS_WI = 488 * MiB, WS_END = 512 * MiB;
constexpr size_t QKV_STRIDE = (WS_K - WS_Q) / 2;
static_assert(WS_V - WS_K == WS_K - WS_Q, "Q|K|V equally spaced");
constexpr int CW_BAR = 4096, CW_QUEUE = 32768;

constexpr int RING_BYTES = 131072, LDSCTL_OFF = RING_BYTES, MISC_OFF = LDSCTL_OFF + 320, ORD_OFF = LDSCTL_OFF + 1024, LDS_BYTES = 147456;

__constant__ float ROPE_INV[32] = {
    1.000000000e+00f, 7.498942614e-01f, 5.623413324e-01f, 4.216965139e-01f, 3.162277639e-01f, 2.371373773e-01f, 1.778279394e-01f, 1.333521307e-01f,
    1.000000015e-01f, 7.498941571e-02f, 5.623413250e-02f, 4.216965288e-02f, 3.162277490e-02f, 2.371373773e-02f, 1.778279431e-02f, 1.333521493e-02f,
    9.999999776e-03f, 7.498941850e-03f, 5.623413250e-03f, 4.216964822e-03f, 3.162277630e-03f, 2.371373586e-03f, 1.778279431e-03f, 1.333521446e-03f,
    1.000000047e-03f, 7.498942432e-04f, 5.623413017e-04f, 4.216965172e-04f, 3.162277571e-04f, 2.371373703e-04f, 1.778279402e-04f, 1.333521504e-04f};

__device__ __forceinline__ float wave_sum(float v) {
#pragma unroll
    for (int o = 1; o < 64; o <<= 1) v += __shfl_xor(v, o);
    return v;
}
__device__ __forceinline__ int crow32(int r, int hi) { return (r & 3) + 8 * (r >> 2) + 4 * hi; }
__device__ __forceinline__ unsigned long long pk4(f32x4 v) { return (unsigned long long)pk2(v.x, v.y) | ((unsigned long long)pk2(v.z, v.w) << 32); }
__device__ __forceinline__ int metarow(int r) { return (r >> 4) * TALLOC + (r & 15); }
__device__ __forceinline__ float bf2f(unsigned short b) { return __uint_as_float((unsigned)b << 16); }

__device__ __forceinline__ v4u widen16(unsigned long long w0, unsigned long long w1) {
    const auto lo = __builtin_amdgcn_permlane16_swap((unsigned)w0, (unsigned)w1, false, false); const auto hi = __builtin_amdgcn_permlane16_swap((unsigned)(w0 >> 32), (unsigned)(w1 >> 32), false, false);
    return v4u{lo[0], hi[0], lo[1], hi[1]};
}
__device__ __forceinline__ int wide_col(int fq, int nstride) { return (fq & 1) * nstride + 8 * (fq >> 1); }
template <class Q> struct EpiOf {
    static constexpr bool PERM = false, AFTER_DRAIN = false;
    Q q;
    __device__ __forceinline__ void operator()(const pg8::f32x4 (&acc)[2][2][4][2], const pg8::Unit& u, int wr, int wc, int fr, int fq) const {
        const int row0 = pg8::arow(u.pm) + wr * 64 + fr;
#pragma unroll
        for (int ai = 0; ai < 2; ++ai)
#pragma unroll
            for (int m = 0; m < 4; ++m)
#pragma unroll
                for (int bj = 0; bj < 2; ++bj) q.quad(row0 + ai * 128 + m * 16, u.pn, bj, wc, fq, acc[ai][bj][m][0], acc[ai][bj][m][1]);
    }
};
struct QuadRope {
    bf16* Q; float* side; const float *cosT, *sinT;
    __device__ __forceinline__ void quad(int row, int pn, int bj, int wc, int fq, f32x4 v0, f32x4 v1) const {
        if (pn < 12) {
            const int t = pn >> 2, g = bj * 4 + wc, hh = (pn & 3) * 4 + (g >> 1), db = 16 * (g & 1) + 4 * fq;
            f32x4 y0 = v0, y1 = v1;
            if (t < 2) {
                const int pos = row >= TALLOC ? row - TALLOC : row;
                const f32x4 c = *(const GAS f32x4*)(cosT + pos * 32 + db), s = *(const GAS f32x4*)(sinT + pos * 32 + db);
                y0 = v0 * c - v1 * s; y1 = v1 * c + v0 * s;
                if (t == 0) { y0 = y0 * QSCALE; y1 = y1 * QSCALE; }
            }
            bf16* dst = Q + (size_t)t * QKV_STRIDE + (size_t)row * 1024 + hh * 64 + db;
            *(GAS unsigned long long*)dst = pk4(y0); *(GAS unsigned long long*)(dst + 32) = pk4(y1);
        } else {
            const int col = 256 * pn + 128 * bj + 32 * wc + 4 * fq - 3072;
            if (col < NSIDE) *(GAS f32x4*)(side + (size_t)row * SIDE_W + col) = v0;
            if (col + 16 < NSIDE) *(GAS f32x4*)(side + (size_t)row * SIDE_W + col + 16) = v1;
        }
    }
};
struct EpiRopeW {
    static constexpr bool PERM = false, AFTER_DRAIN = false;
    QuadRope q;
    __device__ __forceinline__ void operator()(const pg8::f32x4 (&acc)[2][2][4][2], const pg8::Unit& u, int wr, int wc, int fr_in, int fq_in) const {
        int fr = fr_in, fq = fq_in; asm volatile("" : "+v"(fr), "+v"(fq));
        const int row0 = pg8::arow(u.pm) + wr * 64 + fr;
        if (u.pn < 12) {
            const int t = u.pn >> 2;
#pragma unroll
            for (int ai = 0; ai < 2; ++ai)
#pragma unroll
                for (int m = 0; m < 4; ++m) { const int row = row0 + ai * 128 + m * 16;
#pragma unroll
                    for (int bj = 0; bj < 2; ++bj) { const int g = bj * 4 + wc, hh = (u.pn & 3) * 4 + (g >> 1), db = 16 * (g & 1) + 4 * fq;
                        const f32x4 v0 = acc[ai][bj][m][0], v1 = acc[ai][bj][m][1]; f32x4 y0 = v0, y1 = v1;
                        if (t < 2) { const int pos = row >= TALLOC ? row - TALLOC : row;
                            const f32x4 c = *(const GAS f32x4*)(q.cosT + pos * 32 + db), s = *(const GAS f32x4*)(q.sinT + pos * 32 + db);
                            y0 = v0 * c - v1 * s; y1 = v1 * c + v0 * s;
                            if (t == 0) { y0 = y0 * QSCALE; y1 = y1 * QSCALE; } }
                        bf16* dst = q.Q + (size_t)t * QKV_STRIDE + (size_t)row * 1024 + hh * 64 + 16 * (g & 1) + wide_col(fq, 32);
                        *(GAS v4u*)dst = widen16(pk4(y0), pk4(y1)); } }
        } else {
#pragma unroll
            for (int ai = 0; ai < 2; ++ai)
#pragma unroll
                for (int m = 0; m < 4; ++m)
#pragma unroll
                    for (int bj = 0; bj < 2; ++bj) q.quad(row0 + ai * 128 + m * 16, u.pn, bj, wc, fq, acc[ai][bj][m][0], acc[ai][bj][m][1]);
        }
    }
};
struct QuadResid {
    float* H; float sgn;
    __device__ __forceinline__ void quad(int row, int pn, int bj, int wc, int fq, f32x4 v0, f32x4 v1) const {
        float* p = H + (size_t)row * 1024 + 256 * pn + 128 * bj + 32 * wc + 4 * fq;
        const f32x4 a = *(const GAS f32x4*)p, b = *(const GAS f32x4*)(p + 16);
        *(GAS f32x4*)p = a + sgn * v0; *(GAS f32x4*)(p + 16) = b + sgn * v1;
    }
};
struct QuadPlain {
    bf16* U; int ldu;
    __device__ __forceinline__ void quad(int row, int pn, int bj, int wc, int fq, f32x4 v0, f32x4 v1) const {
        bf16* p = U + (size_t)row * ldu + 256 * pn + 128 * bj + 32 * wc + 4 * fq;
        *(GAS unsigned long long*)p = pk4(v0); *(GAS unsigned long long*)(p + 16) = pk4(v1);
    }
};


__device__ __forceinline__ float silu_mul(float g, float v) { return g * v * __builtin_amdgcn_rcpf(1.f + __builtin_amdgcn_exp2f(g * -1.4426950408889634f)); }
struct EpiFfn {
    static constexpr bool PERM = false, AFTER_DRAIN = false;
    bf16* ts;
    bf16 *HL, *HF;
    bf16* ACT;
    const float *cw, *cb;
    __device__ __forceinline__ void operator()(const pg8::f32x4 (&acc)[2][2][4][2], const pg8::Unit& u, int wr, int wc, int fr_in, int fq_in) const {
        int fr = fr_in, fq = fq_in; asm volatile("" : "+v"(fr), "+v"(fq));
        GAS bf16* tsg = (GAS bf16*)ts;
#pragma unroll
        for (int ai = 0; ai < 2; ++ai)
#pragma unroll
            for (int m = 0; m < 4; ++m) { const int R = 128 * ai + 64 * wr + 16 * m + fr;
#pragma unroll
                for (int bj = 0; bj < 2; ++bj) { const int p = 128 * bj + 32 * wc + wide_col(fq, 16); const v4u w = widen16(pk4(acc[ai][bj][m][0]), pk4(acc[ai][bj][m][1]));
                        *(GAS v4u*)(tsg + R * 256 + p) = w;
                        if (ai == 0 && m == 0) { if (wr == 0 && fr < 2) *(GAS v4u*)((GAS bf16*)HF + ((size_t)(u.pm * 2 + fr)) * (2 * FFN_H) + 256 * u.pn + p) = w; }
                        if (ai == 1 && m == 3) { if (wr == 1 && fr >= 14) *(GAS v4u*)((GAS bf16*)HL + ((size_t)(u.pm * 2 + fr - 14)) * (2 * FFN_H) + 256 * u.pn + p) = w; } } }
        asm volatile("s_waitcnt vmcnt(0)\n\ts_barrier" ::: "memory");
        const int t = (wr * 4 + wc) * 64 + fq * 16 + fr, cgp = t & 15, rb = t >> 4, h8 = 8 * cgp, hcol = 128 * u.pn + h8, row0 = pg8::arow(u.pm);
        float wg[3][8], wv[3][8], bg[8], bv[8];
#pragma unroll
        for (int j = 0; j < 3; ++j) { const GAS f32x4* a = (const GAS f32x4*)(cw + (size_t)j * 2 * FFN_H + hcol); const GAS f32x4* b = (const GAS f32x4*)(cw + (size_t)j * 2 * FFN_H + FFN_H + hcol);
            const f32x4 a0 = a[0], a1 = a[1], b0 = b[0], b1 = b[1];
            wg[j][0] = a0.x; wg[j][1] = a0.y; wg[j][2] = a0.z; wg[j][3] = a0.w; wg[j][4] = a1.x; wg[j][5] = a1.y; wg[j][6] = a1.z; wg[j][7] = a1.w;
            wv[j][0] = b0.x; wv[j][1] = b0.y; wv[j][2] = b0.z; wv[j][3] = b0.w; wv[j][4] = b1.x; wv[j][5] = b1.y; wv[j][6] = b1.z; wv[j][7] = b1.w; }
        { const GAS f32x4* a = (const GAS f32x4*)(cb + hcol); const GAS f32x4* b = (const GAS f32x4*)(cb + FFN_H + hcol); const f32x4 a0 = a[0], a1 = a[1], b0 = b[0], b1 = b[1];
          bg[0] = a0.x; bg[1] = a0.y; bg[2] = a0.z; bg[3] = a0.w; bg[4] = a1.x; bg[5] = a1.y; bg[6] = a1.z; bg[7] = a1.w; bv[0] = b0.x; bv[1] = b0.y; bv[2] = b0.z; bv[3] = b0.w; bv[4] = b1.x; bv[5] = b1.y; bv[6] = b1.z; bv[7] = b1.w; }
        const GAS v4u* tg = (const GAS v4u*)(tsg + h8); const GAS v4u* tv = (const GAS v4u*)(tsg + 128 + h8);
        v4u g0 = v4u{0, 0, 0, 0}, g1 = g0, v0 = g0, v1 = g0;
        if (rb > 0) { g0 = __builtin_nontemporal_load(tg + (8 * rb - 2) * 32); g1 = __builtin_nontemporal_load(tg + (8 * rb - 1) * 32); v0 = __builtin_nontemporal_load(tv + (8 * rb - 2) * 32); v1 = __builtin_nontemporal_load(tv + (8 * rb - 1) * 32); }
#pragma unroll
        for (int i = 0; i < 8; ++i) { const int R = 8 * rb + i;
            const v4u g2 = __builtin_nontemporal_load(tg + R * 32), v2 = __builtin_nontemporal_load(tv + R * 32);
            const unsigned gw[3][4] = {{g0.x, g0.y, g0.z, g0.w}, {g1.x, g1.y, g1.z, g1.w}, {g2.x, g2.y, g2.z, g2.w}}, vw[3][4] = {{v0.x, v0.y, v0.z, v0.w}, {v1.x, v1.y, v1.z, v1.w}, {v2.x, v2.y, v2.z, v2.w}};
            unsigned w[4];
#pragma unroll
            for (int e = 0; e < 4; ++e) { float cg0 = bg[2 * e], cg1 = bg[2 * e + 1], cv0 = bv[2 * e], cv1 = bv[2 * e + 1];
#pragma unroll
                for (int j = 0; j < 3; ++j) { cg0 += wg[j][2 * e] * __uint_as_float(gw[j][e] << 16); cg1 += wg[j][2 * e + 1] * __uint_as_float(gw[j][e] & 0xffff0000u);
                    cv0 += wv[j][2 * e] * __uint_as_float(vw[j][e] << 16); cv1 += wv[j][2 * e + 1] * __uint_as_float(vw[j][e] & 0xffff0000u); }
                w[e] = pk2(silu_mul(cg0, cv0), silu_mul(cg1, cv1)); }
            if (R >= 2) *(GAS v4u*)((GAS bf16*)ACT + (size_t)(row0 + R) * FFN_H + hcol) = v4u{w[0], w[1], w[2], w[3]};
            g0 = g1; g1 = g2; v0 = v1; v1 = v2; }
    }
};
struct QuadMetaU {
    bf16* UM;
    __device__ __forceinline__ void quad(int row, int pn, int bj, int wc, int fq, f32x4 v0, f32x4 v1) const {
        const int r = (row >= TALLOC ? 16 + row - TALLOC : row);
        GAS bf16* p = (GAS bf16*)UM + (size_t)r * (2 * FFN_H) + 256 * pn + 128 * bj + 32 * wc + 4 * fq;
        *(GAS unsigned long long*)p = pk4(v0); *(GAS unsigned long long*)(p + 16) = pk4(v1);
    }
};
template <class Epi> __device__ __forceinline__ void run_gemm_epi(LAS unsigned char* lds, const bf16* A, const bf16* Bt, int N, int K, const Epi& E, int G, const int wv_) {
    pg8::Gemm g{A, Bt, MTILES, N, K}; pg8::StaticOrder S; S.init(MTILES, N, G, (int)blockIdx.x);
    pg8::gemm_phase<Epi, pg8::StaticOrder, true, true>(lds, g, S, E, wv_);
}

template <class Q> __device__ __forceinline__ void run_gemm(LAS unsigned char* lds, const bf16* A, const bf16* Bt, int N, int K, const Q& q, int G, const int wv_) {
    pg8::Gemm g{A, Bt, MTILES, N, K}; pg8::StaticOrder S; S.init(MTILES, N, G, (int)blockIdx.x);
    EpiOf<Q> E{q};
    pg8::gemm_phase<EpiOf<Q>, pg8::StaticOrder, true, true>(lds, g, S, E, wv_);
}
template <class Q> __device__ __forceinline__ void meta_gemm(LAS unsigned char* lds, const bf16* A, const bf16* Bt, int N, int K, const Q& q, int vcu, int G, const int wv_) {
    int tid_ = wv_ * 64 + lane_id(); asm volatile("" : "+v"(tid_));
    const int tid = tid_, lane = tid & 63, wid = __builtin_amdgcn_readfirstlane(tid >> 6), r32 = lane & 31, hi = lane >> 5;
    LAS float* tile = (LAS float*)lds;
    for (int pn = vcu; pn < N / 256; pn += G) {
        const bf16* ap = A + (size_t)metarow(r32) * K + 8 * hi;
        const bf16* bp = Bt + (size_t)(256 * pn + 32 * wid + r32) * K + 8 * hi;
        float zf_ = 0.f; asm volatile("" : "+v"(zf_)); f32x16 acc = {zf_, zf_, zf_, zf_, zf_, zf_, zf_, zf_, zf_, zf_, zf_, zf_, zf_, zf_, zf_, zf_};
#pragma unroll 8
        for (int kk = 0; kk < K / 16; ++kk) {
            const bf16x8 a = *(const GAS bf16x8*)(ap + 16 * kk), b = *(const GAS bf16x8*)(bp + 16 * kk);
            acc = __builtin_amdgcn_mfma_f32_32x32x16_bf16(a, b, acc, 0, 0, 0);
        }
#pragma unroll
        for (int r = 0; r < 16; ++r) tile[crow32(r, hi) * 260 + 32 * wid + r32] = acc[r];
        __syncthreads();
#pragma unroll
        for (int i = 0; i < 2; ++i) {
            const int v = tid * 2 + i, r = v >> 5, g = (v >> 2) & 7, fq = v & 3;
            const f32x4 x0 = *(const LAS f32x4*)(tile + r * 260 + 32 * g + 4 * fq), x1 = *(const LAS f32x4*)(tile + r * 260 + 32 * g + 16 + 4 * fq);
            q.quad(metarow(r), pn, g >> 2, g & 3, fq, x0, x1);
        }
        __syncthreads();
    }
}

struct Mat { const float* W; int ldw, koff, Kp, Np, map; bf16* WT; };
__device__ __forceinline__ int rope_sigma(int n) { const int pn = n >> 8, p = n & 255, g = p >> 5, nn = (p >> 4) & 1, r = p & 15; return 256 * pn + 64 * (g >> 1) + 32 * nn + 16 * (g & 1) + r; }
__device__ __forceinline__ int src_col(int map, int n) {
    if (map == 0) return n;
    if (map == 1) return rope_sigma(n);
    if (map == 2) return n < 3072 ? rope_sigma(n) : (n < NIN ? n : -1);
    { const int pn = n >> 8, p = n & 255; return p < 128 ? 128 * pn + p : FFN_H + 128 * pn + (p - 128); }
}
__device__ __forceinline__ void wt_item(const Mat& m, int item, LAS float* scr, int lane) {
    const int nblk = m.Np / 32, kb = item / nblk, nb = item % nblk, k0 = 64 * kb, n0 = 32 * nb;
    const int src = src_col(m.map, n0 + (lane & 31));
#pragma unroll 8
    for (int i = 0; i < 32; ++i) { const int kk = 2 * i + (lane >> 5); scr[kk * 33 + (lane & 31)] = src >= 0 ? m.W[(size_t)(m.koff + k0 + kk) * m.ldw + src] : 0.f; }
    LDS_WAIT(); asm volatile("" ::: "memory");
    const int c = lane & 7;
#pragma unroll
    for (int j = 0; j < 4; ++j) { const int n = (lane >> 3) + 8 * j; const LAS float* s = scr + (8 * c) * 33 + n;
        v4u o; o.x = pk2(s[0 * 33], s[1 * 33]); o.y = pk2(s[2 * 33], s[3 * 33]); o.z = pk2(s[4 * 33], s[5 * 33]); o.w = pk2(s[6 * 33], s[7 * 33]);
        *(v4u*)(m.WT + (size_t)(n0 + n) * m.Kp + k0 + 8 * c) = o; }
    LDS_WAIT(); asm volatile("" ::: "memory");
}
__device__ __forceinline__ void rms_row_bf16(const float* xrow, const float* g, bf16* orow, float* copy, int lane) {
    const GAS f32x4* xr = (const GAS f32x4*)xrow + lane; f32x4 v[4]; float s = 0.f;
#pragma unroll
    for (int j = 0; j < 4; ++j) { v[j] = xr[64 * j]; s += (v[j].x * v[j].x + v[j].y * v[j].y) + (v[j].z * v[j].z + v[j].w * v[j].w); }
    const float r = 1.0f / sqrtf(wave_sum(s) * (1.f / 1024.f) + RMS_EPS);
    GAS unsigned long long* o8 = (GAS unsigned long long*)orow + lane; const GAS f32x4* gr = (const GAS f32x4*)g + lane;
#pragma unroll
    for (int j = 0; j < 4; ++j) { const f32x4 gg = gr[64 * j]; o8[64 * j] = pk4(v[j] * r * gg); if (copy) ((GAS f32x4*)copy + lane)[64 * j] = v[j]; }
}


constexpr int TK_HS = 513, TK_ST_OFF = 66560, TK_TIE_OFF = TK_ST_OFF + 2048, TK_Q_OFF = 90112, TK_CAND_CAP = 1024;
__device__ __forceinline__ void tk_sweep(LAS unsigned char* lds, const bf16* KI, unsigned long long* cand, const float (&wq)[8], int wave, int lane_in, int nbv, int smpR, unsigned* smp, int u,
                                         int rowbase, int pos_q, unsigned klo_q, unsigned khi_q, bool done_q, unsigned shift_q, bool do_hist, bool do_collect, bool track) {
    LAS unsigned* hist = (LAS unsigned*)lds; LAS unsigned* st = (LAS unsigned*)(lds + TK_ST_OFF); LAS unsigned* st_kmax = st + 192; LAS unsigned* cand_cnt = st + 256;
    LAS unsigned char* qlds = lds + TK_Q_OFF;
    int lane = lane_in; asm volatile("" : "+v"(lane));
    const int qi = lane & 31, hi = lane >> 5;
    int sb = wave; if (2 * sb >= nbv) return;
    const GAS bf16* kbase = (const GAS bf16*)KI + (size_t)(rowbase + (smpR ? 32 : qi)) * 64 + hi * 8;
    LAS unsigned char* qlane = qlds + lane * 16; asm volatile("" : "+v"(qlane));
    bf16x8 kc0[4], kc1[4], kn0[4], kn1[4]; unsigned lmax = 0u;
    unsigned klo_c = klo_q == 0x7fffffffu ? 0x80000000u : klo_q, khi_c = khi_q == 0x7fffffffu ? 0x7ffffffeu : khi_q;
    const float f_lo = klo_c <= 0x007fffffu ? -__builtin_inff() : __uint_as_float((klo_c & 0x80000000u) ? (klo_c ^ 0x80000000u) : ~klo_c);
    const float f_hi = khi_c >= 0xff800000u ? __builtin_inff() : (khi_c < 0x007fffffu ? -__builtin_inff() : __uint_as_float((khi_c & 0x80000000u) ? (khi_c ^ 0x80000000u) : ~khi_c));
#define TK_KLD(dst, vv) do { int v_ = (vv); v_ = v_ < nbv ? v_ : nbv - 1; _Pragma("unroll") for (int kk = 0; kk < 4; ++kk) dst[kk] = *(const GAS bf16x8*)(kbase + (size_t)(smpR ? (((v_ * 32 + qi) * smpR) >> 10) * 64 : v_ * 2048) + kk * 16); } while (0)
    TK_KLD(kc0, 2 * sb); TK_KLD(kc1, 2 * sb + 1);
    for (; 2 * sb < nbv; sb += 8) {
        {
            const int v = 2 * sb;
            { const int nv = 2 * (sb + 8); TK_KLD(kn0, nv); TK_KLD(kn1, nv + 1); }
            {
                float sc0[16], sc1[16]; bf16x8 qa[4]; f32x16 accA, accB;
#define TK_QLD(dst, h) _Pragma("unroll") for (int kk = 0; kk < 4; ++kk) dst[kk] = *(const LAS bf16x8*)(qlane + ((h) * 4 + kk) * 1024)
#define TK_MM(acc, kc, q) do { acc = __builtin_amdgcn_mfma_f32_32x32x16_bf16(kc[0], q[0], zero16, 0, 0, 0); _Pragma("unroll") for (int kk = 1; kk < 4; ++kk) acc = __builtin_amdgcn_mfma_f32_32x32x16_bf16(kc[kk], q[kk], acc, 0, 0, 0); } while (0)
#define TK_RELU(x) __int_as_float(max(__float_as_int(x), 0))
#define TK_ACC0(sc, acc, h) _Pragma("unroll") for (int r = 0; r < 16; ++r) asm("v_mul_f32_e32 %0, %1, %2" : "=v"(sc[r]) : "v"(wq[h]), "v"(TK_RELU(acc[r])))
#define TK_ACC(sc, acc, h) _Pragma("unroll") for (int r = 0; r < 16; ++r) asm("v_fmac_f32_e32 %0, %1, %2" : "+v"(sc[r]) : "v"(wq[h]), "v"(TK_RELU(acc[r])))
                float zf_ = 0.f; asm volatile("" : "+v"(zf_)); const f32x16 zero16 = {zf_, zf_, zf_, zf_, zf_, zf_, zf_, zf_, zf_, zf_, zf_, zf_, zf_, zf_, zf_, zf_};
                DILS_B(8);
#define TK_MMA(acc, kc, q) _Pragma("unroll") for (int kk = 0; kk < 4; ++kk) acc = __builtin_amdgcn_mfma_f32_32x32x16_bf16(kc[kk], q[kk], acc, 0, 0, 0)
#define TK_ABS(sc, acc, h) _Pragma("unroll") for (int r = 0; r < 16; ++r) { sc[r] = __builtin_fmaf(__builtin_fabsf(acc[r]), wq[h], sc[r]); asm("" : "+v"(sc[r])); }
                TK_QLD(qa, 8); __builtin_amdgcn_sched_barrier(0);
                f32x16 linA, linB;
                TK_MM(linA, kc0, qa); TK_MM(linB, kc1, qa); TK_QLD(qa, 0); __builtin_amdgcn_sched_barrier(0);
#pragma unroll
                for (int r = 0; r < 16; ++r) { sc0[r] = linA[r]; sc1[r] = linB[r]; }
#define TK_HEAD(h) TK_MM(accA, kc0, qa); TK_MM(accB, kc1, qa); if ((h) < 7) { TK_QLD(qa, ((h) < 7 ? (h) + 1 : 7)); } TK_ABS(sc0, accA, h); TK_ABS(sc1, accB, h); __builtin_amdgcn_sched_barrier(0)
                TK_HEAD(0); TK_HEAD(1); TK_HEAD(2); TK_HEAD(3); TK_HEAD(4); TK_HEAD(5); TK_HEAD(6); TK_HEAD(7);
#undef TK_MMA
#undef TK_ABS
                DILS_E(8);
#undef TK_HEAD
#undef TK_QLD
#undef TK_MM
#undef TK_RELU
#undef TK_ACC0
#undef TK_ACC
#define TK_POST(sc, vv) do { const int v_ = (vv); if (v_ < nbv) { const int kb = v_; const bool edge = !track && ((kb == 0) || (kb >= u));     \
                    unsigned inr = 0u;                                                        \
                    if (!edge && !track) { _Pragma("unroll") for (int r = 15; r >= 0; --r) { float md_; asm("v_med3_f32 %1, %2, %3, %4\n\tv_cmp_eq_f32_e32 vcc, %1, %2\n\tv_addc_co_u32_e32 %0, vcc, %0, %0, vcc" : "+v"(inr), "=&v"(md_) : "v"(sc[r]), "v"(f_lo), "v"(f_hi) : "vcc"); } }     \
                    else { _Pragma("unroll") for (int r = 0; r < 16; ++r) { const int kpos = 32 * kb + crow32(r, hi); const bool valid = !edge || (kpos >= NMETA && kpos <= pos_q); \
                            inr |= (valid && sc[r] >= f_lo && sc[r] <= f_hi) ? (1u << r) : 0u; \
                            if (track) { const unsigned fb = __float_as_uint(sc[r] + 0.0f), key = fb ^ ((unsigned)((int)fb >> 31) | 0x80000000u); lmax = key > lmax ? key : lmax;     \
                                *(GAS unsigned*)(smp + qi * 1024 + v_ * 32 + crow32(r, hi)) = key; \
                                if (!done_q) { unsigned bin = (key - klo_q) >> shift_q; bin = bin > 1023u ? 1023u : bin; __hip_atomic_fetch_add(hist + qi * TK_HS + (bin >> 1), 1u << ((bin & 1u) * 16u), __ATOMIC_RELAXED, __HIP_MEMORY_SCOPE_WORKGROUP); } } } \
                      if (track) inr = 0u; } \
                    if (done_q) inr = 0u; \
                    unsigned ix = 0u;                                                         \
                    if (do_collect && inr) ix = __hip_atomic_fetch_add(cand_cnt + qi, (unsigned)__builtin_popcount(inr), __ATOMIC_RELAXED, __HIP_MEMORY_SCOPE_WORKGROUP); \
                    while (__any(inr != 0u)) {                                                \
                        const bool has = inr != 0u; const unsigned r = has ? (unsigned)__builtin_ctz(inr) : 0u; inr &= inr - 1u; \
                        const bool b0_ = (r & 1u) != 0u, b1_ = (r & 2u) != 0u, b2_ = (r & 4u) != 0u, b3_ = (r & 8u) != 0u;     \
                        const float t0_ = b0_ ? sc[1] : sc[0], t1_ = b0_ ? sc[3] : sc[2], t2_ = b0_ ? sc[5] : sc[4], t3_ = b0_ ? sc[7] : sc[6], t4_ = b0_ ? sc[9] : sc[8], t5_ = b0_ ? sc[11] : sc[10], t6_ = b0_ ? sc[13] : sc[12], t7_ = b0_ ? sc[15] : sc[14]; \
                        const float u0_ = b1_ ? t1_ : t0_, u1_ = b1_ ? t3_ : t2_, u2_ = b1_ ? t5_ : t4_, u3_ = b1_ ? t7_ : t6_; \
                        const float sv = b3_ ? (b2_ ? u3_ : u2_) : (b2_ ? u1_ : u0_); \
                        if (has) { const unsigned fb = __float_as_uint(sv + 0.0f), key = fb ^ ((unsigned)((int)fb >> 31) | 0x80000000u); \
                            if (do_hist) { unsigned bin = (key - klo_q) >> shift_q; bin = bin > 1023u ? 1023u : bin; \
                                __hip_atomic_fetch_add(hist + qi * TK_HS + (bin >> 1), 1u << ((bin & 1u) * 16u), __ATOMIC_RELAXED, __HIP_MEMORY_SCOPE_WORKGROUP); } \
                            if (do_collect) { if (ix < (unsigned)TK_CAND_CAP) *(GAS u32x2*)(cand + (size_t)qi * TK_CAND_CAP + ix) = u32x2{key, (unsigned)(32 * kb + 4 * hi) + (r & 3u) + 8u * (r >> 2)}; ++ix; } } } } } while (0)
                DILS_B(9);
                TK_POST(sc0, v); TK_POST(sc1, v + 1);
                DILS_E(9);
#undef TK_POST
            }
#pragma unroll
            for (int kk = 0; kk < 4; ++kk) { kc0[kk] = kn0[kk]; kc1[kk] = kn1[kk]; }
        }
    }
#undef TK_KLD
    if (track) __hip_atomic_fetch_max(st_kmax + qi, lmax, __ATOMIC_RELAXED, __HIP_MEMORY_SCOPE_WORKGROUP);
}

struct Args { const float* in[20]; float* out; unsigned char* ws; int ph_lo, ph_hi; };
enum { IN_X = 0, IN_META, IN_DA_NORM, IN_DA_WQKV, IN_LQ1, IN_LK1, IN_LQ2, IN_LK2, IN_SUBLN, IN_DA_WO, IN_DSA_NORM, IN_DSA_WIN, IN_IDX_KNORM, IN_DSA_WO, IN_FFN_NORM, IN_FFN_WUP, IN_CONV_W, IN_CONV_B, IN_FFN_WDN, IN_FINAL_NORM };
constexpr int N_PHASES = 25;

__global__ void __launch_bounds__(NWAVES * 64, 2) fwd(Args args) {
    extern __shared__ __attribute__((aligned(16))) unsigned char lds_raw[];
    LAS unsigned char* lds = (LAS unsigned char*)lds_raw;
    volatile LAS unsigned* MISC = (volatile LAS unsigned*)(lds + MISC_OFF);
    const int G = gridDim.x, bx = blockIdx.x, vcu = (G % 8 == 0) ? (bx % 8) * (G / 8) + bx / 8 : bx;
    const int NGW = G * NWAVES, NGT = NGW * 64;
#define PTRS() unsigned char* ws = args.ws; float* outp = args.out; asm volatile("" : "+s"(ws), "+s"(outp)); \
    int tid_ = wave_s * 64 + lane_id(); asm volatile("" : "+v"(tid_)); const int tid = tid_, lane = tid & 63, wave = wave_s; \
    const int gw = vcu * NWAVES + wave, gtid = gw * 64 + lane; (void)gw; (void)gtid; (void)lane; \
    bf16* const WQKV_T = (bf16*)(ws + WS_WQKV); bf16* const WO1_T = (bf16*)(ws + WS_WO1); bf16* const WIN_T = (bf16*)(ws + WS_WIN); bf16* const WO2_T = (bf16*)(ws + WS_WO2); \
    float* const COS = (float*)(ws + WS_COS); float* const SIN = (float*)(ws + WS_SIN); float* const H = (float*)(ws + WS_H); \
    bf16* const XN = (bf16*)(ws + WS_XN); bf16* const QB = (bf16*)(ws + WS_Q); bf16* const KB = (bf16*)(ws + WS_K); bf16* const VB = (bf16*)(ws + WS_V); bf16* const UB = (bf16*)(ws + WS_Q); \
    bf16* const QI = (bf16*)(ws + WS_QI); bf16* const KI = (bf16*)(ws + WS_KI); float* const WI = (float*)(ws + WS_WI); \
    bf16* const O0 = XN; bf16* const O1 = (bf16*)outp; bf16* const ACT = (bf16*)outp; float* const SIDE = outp; unsigned* const MASK = (unsigned*)outp; \
    (void)WQKV_T; (void)WO1_T; (void)WIN_T; (void)WO2_T; (void)COS; (void)SIN; (void)H; (void)XN; (void)QB; (void)KB; (void)VB; (void)UB; (void)QI; (void)KI; (void)WI; (void)O0; (void)O1; (void)ACT; (void)SIDE; (void)MASK
    gu32* ctl = (gu32*)(args.ws + WS_CTL);
    const int wave_s = __builtin_amdgcn_readfirstlane((int)threadIdx.x >> 6);
    for (int u = wave_s * 64 + lane_id(); u < (LDS_BYTES - LDSCTL_OFF) / 4; u += NWAVES * 64) ((LAS unsigned*)(lds + LDSCTL_OFF))[u] = 0u;
    __syncthreads();
    const int lo = args.ph_lo, hi_ph = args.ph_hi;
    const bool use_bar = (hi_ph - lo) > 1;
    XcdBarrier bar; bar.bar = (unsigned*)(ctl + CW_BAR); bar.x = 0; bar.st = nullptr;
    if (use_bar) bar = xcd_barrier_post((unsigned*)(ctl + CW_BAR), MISC + 8, wave_s);
#ifndef REPMASK
#define REPMASK 0u
#endif
#ifndef REPCNT
#define REPCNT 1
#endif
#ifdef DILMASK
#define DIL_B(k) const bool dil_on_ = ((k) - P == (DILMASK) % 100) && (layer == (DILMASK) / 100); const unsigned long long dil_t0_ = dil_on_ ? __builtin_amdgcn_s_memrealtime() : 0ull
#define DIL_E(k) do { if (dil_on_) { const unsigned long long t1_ = __builtin_amdgcn_s_memrealtime(), d_ = t1_ - dil_t0_; while (__builtin_amdgcn_s_memrealtime() - t1_ < d_) __builtin_amdgcn_s_sleep(4); } } while (0)
#else
#define DIL_B(k)
#define DIL_E(k) do { } while (0)
#endif
#define REP_BEGIN(k) for (int rep_ = 0; rep_ <= REPCNT * (int)(((unsigned)(REPMASK) >> (k)) & 1u); ++rep_) { DIL_B(k);
#define REP_END(k) DIL_E(k); if (rep_ < REPCNT * (int)(((unsigned)(REPMASK) >> (k)) & 1u)) xcd_barrier(bar, wave_s); }
#ifndef EN_MASK
#define EN_MASK 0x1fff
#endif
#define IN(k) (lo <= (k) && (k) < hi_ph)
#define INA(a) ((((EN_MASK) >> (a)) & 1) && IN(P + (a)))
#ifdef DIAG_A
#define STAMP(k) do { if (bx == 0 && wave_s == 0 && lane_id() == 0) __hip_atomic_store((unsigned long long*)(args.ws + 65536) + (k), (unsigned long long)__builtin_amdgcn_s_memrealtime(), __ATOMIC_RELAXED, __HIP_MEMORY_SCOPE_AGENT); } while (0)
#else
#define STAMP(k) do { } while (0)
#endif
#define SEAM(k) do { if (IN(k) && IN((k) + 1)) { xcd_barrier(bar, wave_s); STAMP((k) + 1); } } while (0)

#ifndef FULLREP
#define FULLREP 0
#endif
    for (int full_ = 0; full_ <= FULLREP; ++full_) {
    STAMP(0);
    if (((EN_MASK >> 12) & 1) && IN(0)) { PTRS(); constexpr int P = -1000, layer = -1; REP_BEGIN(0)
        LAS float* scr = (LAS float*)(lds + wave * 16384);
        constexpr int I0 = 16 * 96, I1 = 16 * 32, I2 = 16 * 120, I3 = 16 * 32, IUP = 16 * 176, IDN = 44 * 32;
        constexpr int NITEMS = I0 + I1 + I2 + I3 + 2 * (IUP + IDN);
        for (int it = gw; it < NITEMS; it += NGW) {
            int r = it; Mat m;
            if (r < I0) m = Mat{args.in[IN_DA_WQKV], 3072, 0, 1024, 3072, 1, WQKV_T};
            else if ((r -= I0) < I1) m = Mat{args.in[IN_DA_WO], 1024, 0, 1024, 1024, 0, WO1_T};
            else if ((r -= I1) < I2) m = Mat{args.in[IN_DSA_WIN], NIN, 0, 1024, NIN_PAD, 2, WIN_T};
            else if ((r -= I2) < I3) m = Mat{args.in[IN_DSA_WO], 1024, 0, 1024, 1024, 0, WO2_T};
            else { r -= I3; const int per = IUP + IDN, l = r / per; r -= l * per;
                const float* wup = args.in[IN_FFN_WUP] + (size_t)l * 1024 * 2 * FFN_H; const float* wdn = args.in[IN_FFN_WDN] + (size_t)l * FFN_H * 1024;
                if (r < IUP) m = Mat{wup, 2 * FFN_H, 0, 1024, 2 * FFN_H, 3, (bf16*)(ws + WS_WUP + l * 11 * MiB)};
                else { r -= IUP; m = Mat{wdn, 1024, 0, FFN_H, 1024, 0, (bf16*)(ws + WS_WDN + l * (11 * MiB / 2))}; } }
            wt_item(m, r, scr, lane);
        }
        for (int i = gtid; i < TALLOC * 32; i += NGT) { const float ang = (float)(i >> 5) * ROPE_INV[i & 31]; COS[i] = (float)cos((double)ang); SIN[i] = (float)sin((double)ang); }
        for (int r = gw; r < NBATCH * TREAL; r += NGW) { const int b = r / TREAL, pos = r - b * TREAL, row = b * TALLOC + pos;
            const float* src = pos < NMETA ? args.in[IN_META] + (size_t)pos * 1024 : args.in[IN_X] + ((size_t)b * SEQL + pos - NMETA) * 1024;
            rms_row_bf16(src, args.in[IN_DA_NORM], XN + (size_t)row * 1024, H + (size_t)row * 1024, lane); }
        for (int r = gw; r < 2 * NBATCH * (TALLOC - TREAL); r += NGW) { const int which = r / (NBATCH * (TALLOC - TREAL)), rr = r % (NBATCH * (TALLOC - TREAL)), b = rr / (TALLOC - TREAL), pos = TREAL + rr % (TALLOC - TREAL);
            v4u* p = (v4u*)(KB + (size_t)which * QKV_STRIDE + (size_t)(b * TALLOC + pos) * 1024); unsigned z = 0u; asm volatile("" : "+v"(z)); p[lane] = v4u{z, z, z, z}; p[lane + 64] = v4u{z, z, z, z}; }
    REP_END(0) }
    SEAM(0);

    for (int layer = 0; layer < 2; ++layer) {
        const int P = 1 + 12 * layer;
#ifdef IDLE_US
        if (layer == IDLE_AT) { const unsigned long long t0_ = __builtin_amdgcn_s_memrealtime(); while (__builtin_amdgcn_s_memrealtime() - t0_ < 100ull * IDLE_US) __builtin_amdgcn_s_sleep(8); }
#endif
        if (INA(0)) { PTRS(); REP_BEGIN(P + 0)
            const QuadRope q{QB, SIDE, COS, SIN};
            const bf16* Wt = layer == 0 ? WQKV_T : WIN_T; const int N = layer == 0 ? 3072 : NIN_PAD;
            run_gemm(lds, XN, Wt, N, 1024, q, G, wave_s);
            meta_gemm(lds, XN, Wt, N, 1024, q, vcu, G, wave_s);
        REP_END(P + 0) }
        SEAM(P + 0);
        if (INA(1)) { PTRS(); REP_BEGIN(P + 1)
            if (layer == 0) {
                LAS int* ord = (LAS int*)(lds + ORD_OFF);
                constexpr int NSTREAM = 32;
                if (G % NSTREAM == 0) {
                    const int cps = G / NSTREAM, s = vcu / cps;
                    const int b = s >> 4, h = (s >> 1) & 7, c = s & 1;
                    gu32* qcnt = ctl + CW_QUEUE + 64 * s;
                    for (;;) {
                        if (wave_s == 0 && lane_id() == 0) ord[0] = (int)__hip_atomic_fetch_add(qcnt, 1u, RLX_AGENT);
                        __syncthreads();
                        const int i = __builtin_amdgcn_readfirstlane(ord[0]);
                        __syncthreads();
                        if (i >= 65) break;
                        attn_body::attn_unit<8, false, 2>(b, 2 * h + c, 2 * h, 64 - i, (const attn_body::bf16*)QB, (const attn_body::bf16*)KB, (const attn_body::bf16*)VB, (attn_body::bf16*)(c ? O1 : O0), nullptr, (char*)lds_raw, wave_s);
                    }
                } else {
                    for (int uid = vcu; uid < NSTREAM * 65; uid += G) { const int s = uid / 65, qb = 64 - uid % 65, b = s >> 4, h = (s >> 1) & 7, c = s & 1;
                        attn_body::attn_unit<8, false, 2>(b, 2 * h + c, 2 * h, qb, (const attn_body::bf16*)QB, (const attn_body::bf16*)KB, (const attn_body::bf16*)VB, (attn_body::bf16*)(c ? O1 : O0), nullptr, (char*)lds_raw, wave_s); }
                }
            } else {
                for (int r = gw; r < NBATCH * TREAL; r += NGW) { const int b = r / TREAL, pos = r - b * TREAL, row = b * TALLOC + pos;
                    const float* src = SIDE + (size_t)row * SIDE_W; const int h = lane >> 3, d4 = (lane & 7) * 4;
                    const f32x4 c = *(const f32x4*)(COS + pos * 32 + d4), s = *(const f32x4*)(SIN + pos * 32 + d4);
                    { const f32x4 x1 = *(const f32x4*)(src + h * 64 + d4), x2 = *(const f32x4*)(src + h * 64 + 32 + d4);
                      bf16* dst = QI + (size_t)row * 512 + h * 64 + d4; *(unsigned long long*)dst = pk4(x1 * c - x2 * s); *(unsigned long long*)(dst + 32) = pk4(x2 * c + x1 * s); }
                    { f32x4 k1 = *(const f32x4*)(src + 512 + d4), k2 = *(const f32x4*)(src + 544 + d4);
                      float ss = (k1.x * k1.x + k1.y * k1.y) + (k1.z * k1.z + k1.w * k1.w) + (k2.x * k2.x + k2.y * k2.y) + (k2.z * k2.z + k2.w * k2.w);
                      ss += __shfl_xor(ss, 1); ss += __shfl_xor(ss, 2); ss += __shfl_xor(ss, 4);
                      const float rr = 1.0f / sqrtf(ss * (1.f / 64.f) + RMS_EPS);
                      const f32x4 g1 = *(const f32x4*)(args.in[IN_IDX_KNORM] + d4), g2 = *(const f32x4*)(args.in[IN_IDX_KNORM] + 32 + d4);
                      k1 = k1 * rr * g1; k2 = k2 * rr * g2;
                      if (lane < 8) { bf16* dst = KI + (size_t)row * 64 + d4; *(unsigned long long*)dst = pk4(k1 * c - k2 * s); *(unsigned long long*)(dst + 32) = pk4(k2 * c + k1 * s); } }
                    if (lane < 8) WI[(size_t)row * 8 + lane] = src[576 + lane] * (0.35355339059327373f * 0.125f);
                }
            }
        REP_END(P + 1) }
        SEAM(P + 1);
        if (INA(2)) { PTRS(); REP_BEGIN(P + 2)
            if (layer == 0) {
                const int lane = lane_id();
                float lam;
                { const float a1 = args.in[IN_LQ1][lane] * args.in[IN_LK1][lane], a2 = args.in[IN_LQ2][lane] * args.in[IN_LK2][lane];
                  lam = expf(wave_sum(a1)) - expf(wave_sum(a2)) + LAMBDA_INIT0; }
                for (int r = gw; r < NBATCH * TREAL; r += NGW) { const int b = r / TREAL, pos = r - b * TREAL, row = b * TALLOC + pos;
                    const v4u* p0 = (const v4u*)(O0 + (size_t)row * 1024 + lane * 16); const v4u* p1 = (const v4u*)(O1 + (size_t)row * 1024 + lane * 16);
                    const v4u a0 = p0[0], a1 = p0[1], b0 = p1[0], b1 = p1[1];
                    const unsigned aw[8] = {a0.x, a0.y, a0.z, a0.w, a1.x, a1.y, a1.z, a1.w}, bw[8] = {b0.x, b0.y, b0.z, b0.w, b1.x, b1.y, b1.z, b1.w};
                    float o[16]; float ss = 0.f;
#pragma unroll
                    for (int i = 0; i < 8; ++i) { o[2 * i] = __uint_as_float(aw[i] << 16) - lam * __uint_as_float(bw[i] << 16); o[2 * i + 1] = __uint_as_float(aw[i] & 0xffff0000u) - lam * __uint_as_float(bw[i] & 0xffff0000u);
                        ss += o[2 * i] * o[2 * i] + o[2 * i + 1] * o[2 * i + 1]; }
                    ss += __shfl_xor(ss, 1); ss += __shfl_xor(ss, 2); ss += __shfl_xor(ss, 4);
                    const float rr = (1.0f - LAMBDA_INIT0) / sqrtf(ss * (1.f / 128.f) + RMS_EPS);
                    const float* sg = args.in[IN_SUBLN] + (lane & 7) * 16; unsigned w[8];
#pragma unroll
                    for (int i = 0; i < 8; ++i) w[i] = pk2(o[2 * i] * rr * sg[2 * i], o[2 * i + 1] * rr * sg[2 * i + 1]);
                    v4u* dst = (v4u*)(QB + (size_t)row * 1024 + lane * 16); dst[0] = v4u{w[0], w[1], w[2], w[3]}; dst[1] = v4u{w[4], w[5], w[6], w[7]};
                }
            } else {
                LAS unsigned* hist = (LAS unsigned*)lds;
                LAS unsigned* mrow = (LAS unsigned*)lds;
                LAS unsigned* st_klo = (LAS unsigned*)(lds + TK_ST_OFF), *st_khi = st_klo + 32, *st_cab = st_klo + 64, *st_done = st_klo + 96, *tie_cnt = st_klo + 128, *st_shift = st_klo + 160, *st_kmax = st_klo + 192, *st_need = st_klo + 224, *cand_cnt = st_klo + 256, *st_flag = st_klo + 288;
                LAS unsigned* tie_key = (LAS unsigned*)(lds + TK_TIE_OFF), *tie_pos = tie_key + 32 * TIE_CAP;
                LAS unsigned char* qlds = lds + TK_Q_OFF;
                unsigned long long* cand = (unsigned long long*)XN + (size_t)vcu * 32 * TK_CAND_CAP;
                unsigned* smp = (unsigned*)cand;
                constexpr int NUNIT = 2 * 513;
                for (int round = 0;; ++round) {
                    int tl = wave_s * 64 + lane_id(); asm volatile("" : "+v"(tl));
                    const int lane = tl & 63, wave = __builtin_amdgcn_readfirstlane(tl >> 6), qi = lane & 31, hi = lane >> 5;
                    const int rank = round * G + ((round & 1) ? (G - 1 - vcu) : vcu); if (rank >= NUNIT) break;
#ifdef TK_ABL
                    if (rep_ == 0 && (TK_ABL & 256) && round == 0) continue;
#endif
                    const int b = rank & 1, u = 512 - (rank >> 1), q_lo = 32 * u, rowbase = b * TALLOC, pos_q = q_lo + qi, NB = u + 1;
                    const bool sel = u >= 8, active = pos_q < TREAL;
                    if (!sel) {
                        for (int i = tl; i < 32 * 130; i += NWAVES * 64) { const int q = i / 130, w4 = (i - q * 130) * 4, pos = q_lo + q; unsigned wd[4];
#pragma unroll
                            for (int e = 0; e < 4; ++e) { const int lo32 = 32 * (w4 + e); wd[e] = pos >= lo32 + 31 ? 0xffffffffu : (pos < lo32 ? 0u : ((2u << (pos - lo32)) - 1u)); }
                            *(v4u*)(MASK + (size_t)(rowbase + pos) * MWORDS + w4) = v4u{wd[0], wd[1], wd[2], wd[3]}; }
                        continue;
                    }
                    const int prow = active ? pos_q : TREAL - 1;
                    DILS_B(1);
                    float wq[8];
                    { const f32x4 w0 = *(const f32x4*)(WI + (size_t)(rowbase + prow) * 8), w1 = *(const f32x4*)(WI + (size_t)(rowbase + prow) * 8 + 4);
                      wq[0] = 0.5f * w0.x; wq[1] = 0.5f * w0.y; wq[2] = 0.5f * w0.z; wq[3] = 0.5f * w0.w; wq[4] = 0.5f * w1.x; wq[5] = 0.5f * w1.y; wq[6] = 0.5f * w1.z; wq[7] = 0.5f * w1.w; }
                    { const bf16* qp = QI + (size_t)(rowbase + prow) * 512 + hi * 8 + wave * 64;
#pragma unroll
                      for (int kk = 0; kk < 4; ++kk) *(LAS bf16x8*)(qlds + (wave * 4 + kk) * 1024 + lane * 16) = *(const bf16x8*)(qp + kk * 16); }
                    if (wave < 4) {
                        const bf16* qp = QI + (size_t)(rowbase + prow) * 512 + hi * 8 + wave * 16; float a[8];
#pragma unroll
                        for (int e = 0; e < 8; ++e) a[e] = 0.f;
#pragma unroll
                        for (int h = 0; h < 8; ++h) { const v4u qv = *(const v4u*)(qp + h * 64); const unsigned qw[4] = {qv.x, qv.y, qv.z, qv.w};
#pragma unroll
                            for (int e = 0; e < 4; ++e) { a[2 * e] += wq[h] * __uint_as_float(qw[e] << 16); a[2 * e + 1] += wq[h] * __uint_as_float(qw[e] & 0xffff0000u); } }
                        unsigned ph[4];
#pragma unroll
                        for (int e = 0; e < 4; ++e) ph[e] = pk2(a[2 * e], a[2 * e + 1]);
                        *(LAS v4u*)(qlds + (8 * 4 + wave) * 1024 + lane * 16) = v4u{ph[0], ph[1], ph[2], ph[3]};
                    }
#ifdef TK_ABL
                    const int tk_abl = (rep_ == 0) ? TK_ABL : 0;
#else
                    constexpr int tk_abl = 0;
#endif
                    const bool use_sample = u >= 40;
                    if (tl < 32) { const bool inact = q_lo + tl >= TREAL; unsigned need = (unsigned)TOPK_NM;
                        if (use_sample) { const float m = 240.f * 1024.f / (float)(q_lo + tl - 15); need = (unsigned)(m + 4.f * sqrtf(m) + 2.f); }
                        st_klo[tl] = 0u; st_khi[tl] = 0xffffffffu; st_cab[tl] = 0u; st_done[tl] = inact ? 1u : 0u; tie_cnt[tl] = 0u; st_shift[tl] = 22u; st_kmax[tl] = 0u; st_need[tl] = need; cand_cnt[tl] = 0u;
                        if (tl == 0) st_flag[0] = use_sample ? 0u : 1u; }
                    __syncthreads();
                    DILS_E(1);
                    unsigned klo_q = 0u, khi_q = 0xffffffffu;
                    { int stage = use_sample ? 0 : 1; bool collected = false;
                        for (int it = 0; it < 16; ++it) {
                            DILS_B(7);
                            { unsigned z = 0u; asm volatile("" : "+v"(z)); for (int i = tl; i < 32 * TK_HS / 4; i += NWAVES * 64) ((LAS v4u*)hist)[i] = v4u{z, z, z, z}; }
                            klo_q = st_klo[qi]; khi_q = st_khi[qi]; const bool done_q = st_done[qi] != 0u; const unsigned shift_q = st_shift[qi];
                            const bool collect = use_sample && stage == 1 && !collected;
                            __syncthreads();
                            DILS_E(7);
                            DILS_B(2); DILS_B(3);
                            if (stage == 0 && it > 0) {
                                int ll = lane; asm volatile("" : "+v"(ll));
                                for (int qq = 4 * wave; qq < 4 * wave + 4; ++qq) { if (st_done[qq] != 0u) continue; const unsigned kl = st_klo[qq], kh = st_khi[qq], sh = st_shift[qq]; unsigned ky[16];
#pragma unroll
                                    for (int k = 0; k < 16; ++k) ky[k] = __hip_atomic_load(smp + qq * 1024 + 64 * k + ll, __ATOMIC_RELAXED, __HIP_MEMORY_SCOPE_AGENT);
#pragma unroll
                                    for (int k = 0; k < 16; ++k) if (ky[k] >= kl && ky[k] <= kh) { unsigned bin = (ky[k] - kl) >> sh; bin = bin > 1023u ? 1023u : bin;
                                        __hip_atomic_fetch_add(hist + qq * TK_HS + (bin >> 1), 1u << ((bin & 1u) * 16u), __ATOMIC_RELAXED, __HIP_MEMORY_SCOPE_WORKGROUP); } }
                            } else {
                                tk_sweep(lds, KI, cand, wq, wave, lane, stage ? NB : 32, stage ? 0 : 32 * (u - 1), smp, u, rowbase, pos_q, klo_q, khi_q, done_q, shift_q, true, collect, stage == 0);
                                if (stage == 0) asm volatile("s_waitcnt vmcnt(0)" ::: "memory");
                            }
                            if (stage == 0) DILS_E(2); else DILS_E(3);
                            if (collect) collected = true;
                            DILS_B(4);
                            if ((tk_abl & 1) && stage == 1) { __syncthreads(); break; }
                            DILS_B(10);
                            __syncthreads();
                            DILS_E(10);
                            { unsigned hw[4][8], sm[4], suf[4], dn[4];
#pragma unroll
                              for (int j = 0; j < 4; ++j) { dn[j] = st_done[4 * wave + j];
#pragma unroll
                                  for (int i = 0; i < 8; ++i) hw[j][i] = hist[(4 * wave + j) * TK_HS + 8 * lane + i]; }
#pragma unroll
                              for (int j = 0; j < 4; ++j) { unsigned t_ = 0u;
#pragma unroll
                                  for (int i = 0; i < 8; ++i) t_ += (hw[j][i] & 0xffffu) + (hw[j][i] >> 16);
                                  sm[j] = t_; suf[j] = t_; }
#pragma unroll
                              for (int off = 1; off < 64; off <<= 1) {
#pragma unroll
                                  for (int j = 0; j < 4; ++j) { const unsigned t = (unsigned)__shfl_down((int)suf[j], off); if (lane + off < 64) suf[j] += t; } }
#pragma unroll
                              for (int j = 0; j < 4; ++j) { const int qq = 4 * wave + j;
                                if (dn[j] != 0u) continue;
                                const unsigned need = st_need[qq] - st_cab[qq], total = (unsigned)__shfl((int)suf[j], 0);
                                if (total < need) {
                                    if (lane == 0) { const unsigned ok = st_klo[qq]; st_cab[qq] += total; st_khi[qq] = ok - 1u; st_klo[qq] = 0u; st_flag[0] = 1u;
                                        const int wb = 32 - __builtin_clz((ok - 1u) | 1u); st_shift[qq] = (unsigned)(wb > 10 ? wb - 10 : 0); if (ok == 0u) st_done[qq] = 1u; }
                                } else {
                                    const unsigned long long bal = __ballot(suf[j] >= need);
                                    const int Ls = 63 - __builtin_clzll(bal | 1ull);
                                    if (lane == Ls) { unsigned cum = suf[j] - sm[j], above = 0u, cnt = 0u; int jb = 0; bool found = false;
#pragma unroll
                                        for (int i = 15; i >= 0; --i) { const unsigned ci = (i & 1) ? (hw[j][i >> 1] >> 16) : (hw[j][i >> 1] & 0xffffu); if (!found) { if (cum + ci >= need) { found = true; jb = i; above = cum; cnt = ci; } else cum += ci; } }
                                        const unsigned sh = st_shift[qq], jbin = (unsigned)(16 * lane + jb), klo_n = st_klo[qq] + (jbin << sh), kho = st_khi[qq];
                                        unsigned khi_n = klo_n + ((1u << sh) - 1u); if (khi_n < klo_n || khi_n > kho || jbin == 1023u) khi_n = kho;
                                        st_cab[qq] += above; st_klo[qq] = klo_n; st_khi[qq] = khi_n;
                                        st_done[qq] = (cnt <= (stage == 0 ? 4u : (unsigned)TIE_CAP) || khi_n == klo_n) ? 1u : 0u;
                                        const unsigned wdt = khi_n - klo_n; const int wb = 32 - __builtin_clz(wdt | 1u); st_shift[qq] = (unsigned)(wb > 10 ? wb - 10 : 0); }
                                }
                              }
                            }
                            __syncthreads();
                            DILS_E(4);
                            if (__all(st_done[qi] != 0u)) {
                                if (stage != 0) break;
                                __syncthreads();
                                if (tl < 32) { const bool inact = q_lo + tl >= TREAL; const unsigned L = st_klo[tl], km = st_kmax[tl]; const unsigned span = km > L ? km - L : 1u;
                                    const unsigned w2 = span > 0x7fffffffu ? 0xffffffffu : 2u * span; int sh = 32 - __builtin_clz(w2 | 1u) - 10; sh = sh < 0 ? 0 : (sh > 22 ? 22 : sh);
                                    st_klo[tl] = L; st_khi[tl] = 0xffffffffu; st_cab[tl] = 0u; st_done[tl] = inact ? 1u : 0u; st_shift[tl] = (unsigned)sh; st_need[tl] = (unsigned)TOPK_NM; }
                                stage = 1;
                                __syncthreads();
                            }
                        }
                    }
                    DILS_B(5);
                    { bool redo = (st_flag[0] != 0u || !__all(cand_cnt[qi] <= (unsigned)TK_CAND_CAP)) && !(tk_abl & 2);
                      if (redo) { __syncthreads(); if (tl < 32) cand_cnt[tl] = 0u; __syncthreads();
                          tk_sweep(lds, KI, cand, wq, wave, lane, NB, 0, smp, u, rowbase, pos_q, st_klo[qi], 0xffffffffu, !active, 0u, false, true, false); } }
                    DILS_E(5);
                    DILS_B(6);
                    asm volatile("s_waitcnt vmcnt(0)" ::: "memory");
                    for (int i = tl; i < 32 * MWORDS; i += NWAVES * 64) mrow[i] = ((i % MWORDS) == 0) ? 0xffffu : 0u;
                    __syncthreads();
                    int lf_ = lane; asm volatile("" : "+v"(lf_));
                    if (!(tk_abl & 4))
                    for (int q = 4 * wave; q < 4 * wave + 4; ++q) { const int lane = lf_;
                        if (q_lo + q >= TREAL) continue;
                        unsigned n = cand_cnt[q]; n = n > (unsigned)TK_CAND_CAP ? (unsigned)TK_CAND_CAP : n; const unsigned kl = st_klo[q], kh = st_khi[q];
                        const unsigned long long* cq = cand + (size_t)q * TK_CAND_CAP;
                        for (unsigned base = 0; base < n; base += 256u) {
                            unsigned long long e[4];
#pragma unroll
                            for (int k = 0; k < 4; ++k) { const unsigned i = base + 64u * k + (unsigned)lane; e[k] = i < n ? __hip_atomic_load(cq + i, __ATOMIC_RELAXED, __HIP_MEMORY_SCOPE_AGENT) : 0ull; }
#pragma unroll
                            for (int k = 0; k < 4; ++k) { const unsigned i = base + 64u * k + (unsigned)lane; const unsigned key = (unsigned)e[k], kpos = (unsigned)(e[k] >> 32);
                                if (i < n) { if (key > kh) __hip_atomic_fetch_or(mrow + q * MWORDS + (kpos >> 5), 1u << (kpos & 31u), __ATOMIC_RELAXED, __HIP_MEMORY_SCOPE_WORKGROUP);
                                    else if (key >= kl) { const unsigned ix = __hip_atomic_fetch_add(tie_cnt + q, 1u, __ATOMIC_RELAXED, __HIP_MEMORY_SCOPE_WORKGROUP);
                                        if (ix < (unsigned)TIE_CAP) { tie_key[q * TIE_CAP + ix] = key; tie_pos[q * TIE_CAP + ix] = kpos; } } } }
                        }
                        asm volatile("s_waitcnt lgkmcnt(0)" ::: "memory");
                        unsigned cnt = tie_cnt[q]; cnt = cnt > (unsigned)TIE_CAP ? (unsigned)TIE_CAP : cnt; const unsigned ntake = (unsigned)TOPK_NM - st_cab[q];
                        const bool have = (unsigned)lane < cnt; const unsigned ki = have ? tie_key[q * TIE_CAP + lane] : 0u, pi = have ? tie_pos[q * TIE_CAP + lane] : 0u; unsigned rk = 0u;
                        for (unsigned j2 = 0; j2 < cnt; ++j2) { const unsigned kj = (unsigned)__builtin_amdgcn_readlane((int)ki, (int)j2), pj = (unsigned)__builtin_amdgcn_readlane((int)pi, (int)j2); rk += (kj > ki || (kj == ki && pj < pi)) ? 1u : 0u; }
                        if (have && rk < ntake && !(tk_abl & 8)) __hip_atomic_fetch_or(mrow + q * MWORDS + (pi >> 5), 1u << (pi & 31u), __ATOMIC_RELAXED, __HIP_MEMORY_SCOPE_WORKGROUP);
                    }
                    __syncthreads();
                    for (int i = tl; i < 32 * 130; i += NWAVES * 64) { const int q = i / 130, w4 = (i - q * 130) * 4;
                        if (q_lo + q < TREAL) *(v4u*)(MASK + (size_t)(rowbase + q_lo + q) * MWORDS + w4) = *(const LAS v4u*)(mrow + q * MWORDS + w4); }
                    __syncthreads();
                    DILS_E(6);
                }
            }
        REP_END(P + 2) }
        SEAM(P + 2);
        if (layer == 1) {
            if (INA(3)) { PTRS(); REP_BEGIN(P + 3)
                LAS int* ord = (LAS int*)(lds + ORD_OFF);
                constexpr int NSTREAM = 32;
                if (G % NSTREAM == 0) {
                    const int cps = G / NSTREAM, s = vcu / cps;
                    gu32* qcnt = ctl + CW_QUEUE + 64 * (32 + s);
                    for (;;) {
                        if (wave_s == 0 && lane_id() == 0) ord[0] = (int)__hip_atomic_fetch_add(qcnt, 1u, RLX_AGENT);
                        __syncthreads();
                        const int i = __builtin_amdgcn_readfirstlane(ord[0]);
                        __syncthreads();
                        if (i >= 65) break;
                        attn_body::attn_unit<8, true, 1>(s >> 4, s & 15, s & 15, 64 - i, (const attn_body::bf16*)QB, (const attn_body::bf16*)KB, (const attn_body::bf16*)VB, (attn_body::bf16*)XN, MASK, (char*)lds_raw, wave_s);
                    }
                } else {
                    for (int uid = vcu; uid < NSTREAM * 65; uid += G) { const int s = uid / 65, qb = 64 - uid % 65;
                        attn_body::attn_unit<8, true, 1>(s >> 4, s & 15, s & 15, qb, (const attn_body::bf16*)QB, (const attn_body::bf16*)KB, (const attn_body::bf16*)VB, (attn_body::bf16*)XN, MASK, (char*)lds_raw, wave_s); }
                }
            REP_END(P + 3) }
            SEAM(P + 3);
        } else { STAMP(P + 4); }
        if (INA(4)) { PTRS(); REP_BEGIN(P + 4)
            const QuadResid q{H, (rep_ & 1) ? -1.f : 1.f};
            const bf16* Wt = layer == 0 ? WO1_T : WO2_T;
            const bf16* Ain = layer == 0 ? QB : XN;
            run_gemm(lds, Ain, Wt, 1024, 1024, q, G, wave_s);
            meta_gemm(lds, Ain, Wt, 1024, 1024, q, vcu, G, wave_s);
        REP_END(P + 4) }
        SEAM(P + 4);
        if (INA(5)) { PTRS(); REP_BEGIN(P + 5)
            for (int r = gw; r < NBATCH * TREAL; r += NGW) { const int b = r / TREAL, pos = r - b * TREAL, row = b * TALLOC + pos;
                rms_row_bf16(H + (size_t)row * 1024, args.in[IN_FFN_NORM] + layer * 1024, XN + (size_t)row * 1024, nullptr, lane); }
        REP_END(P + 5) }
        SEAM(P + 5);
        if (INA(6)) { PTRS(); const bf16* WU = (const bf16*)(ws + WS_WUP + layer * 11 * MiB); bf16* ACTF = (bf16*)(ws + WS_Q);
            const float* cw = args.in[IN_CONV_W] + (size_t)layer * 3 * 2 * FFN_H; const float* cb = args.in[IN_CONV_B] + (size_t)layer * 2 * FFN_H;
            unsigned char* dob = (unsigned char*)outp;
            REP_BEGIN(P + 6)
            const EpiFfn E{(bf16*)(dob + DO_TS) + (size_t)blockIdx.x * 65536, (bf16*)(dob + DO_HL), (bf16*)(dob + DO_HF), ACTF, cw, cb};
            run_gemm_epi(lds, XN, WU, 2 * FFN_H, 1024, E, G, wave_s);
            const QuadMetaU qm{(bf16*)(dob + DO_UM)}; meta_gemm(lds, XN, WU, 2 * FFN_H, 1024, qm, vcu, G, wave_s);
            REP_END(P + 6) }
        SEAM(P + 6);
        if (INA(7)) { PTRS(); bf16* ACTF = (bf16*)(ws + WS_Q); unsigned char* dob = (unsigned char*)outp;
            const GAS bf16* HL = (const GAS bf16*)(dob + DO_HL); const GAS bf16* HF = (const GAS bf16*)(dob + DO_HF); const GAS bf16* UM = (const GAS bf16*)(dob + DO_UM);
            const float* cw = args.in[IN_CONV_W] + (size_t)layer * 3 * 2 * FFN_H; const float* cb = args.in[IN_CONV_B] + (size_t)layer * 2 * FFN_H;
            constexpr int NC = FFN_H / 8, NROW = 32 + 256;
            for (int it = gtid; it < NROW * NC; it += NGT) { const int rr = it / NC, h8 = (it - rr * NC) * 8, scol = 256 * (h8 >> 7) + (h8 & 127);
                const GAS bf16* src[3]; int row;
                if (rr < 32) { const int b = rr >> 4, j = rr & 15; row = b * TALLOC + j;
                    src[2] = UM + (size_t)rr * (2 * FFN_H); src[1] = j >= 1 ? UM + (size_t)(rr - 1) * (2 * FFN_H) : nullptr; src[0] = j >= 2 ? UM + (size_t)(rr - 2) * (2 * FFN_H) : nullptr; }
                else { const int q = rr - 32, pm = q >> 1, r01 = q & 1; row = pg8::arow(pm) + r01;
                    const GAS bf16* pl0 = (pm & 63) ? HL + (size_t)((pm - 1) * 2 + 0) * (2 * FFN_H) : UM + (size_t)((pm >> 6) * 16 + 14) * (2 * FFN_H);
                    const GAS bf16* pl1 = (pm & 63) ? HL + (size_t)((pm - 1) * 2 + 1) * (2 * FFN_H) : UM + (size_t)((pm >> 6) * 16 + 15) * (2 * FFN_H);
                    const GAS bf16* f0 = HF + (size_t)(pm * 2 + 0) * (2 * FFN_H); const GAS bf16* f1 = HF + (size_t)(pm * 2 + 1) * (2 * FFN_H);
                    src[2] = r01 ? f1 : f0; src[1] = r01 ? f0 : pl1; src[0] = r01 ? pl1 : pl0; }
                float ag[8], av[8];
                { const f32x4 b0 = *(const GAS f32x4*)(cb + h8), b1 = *(const GAS f32x4*)(cb + h8 + 4), d0 = *(const GAS f32x4*)(cb + FFN_H + h8), d1 = *(const GAS f32x4*)(cb + FFN_H + h8 + 4);
                  ag[0] = b0.x; ag[1] = b0.y; ag[2] = b0.z; ag[3] = b0.w; ag[4] = b1.x; ag[5] = b1.y; ag[6] = b1.z; ag[7] = b1.w; av[0] = d0.x; av[1] = d0.y; av[2] = d0.z; av[3] = d0.w; av[4] = d1.x; av[5] = d1.y; av[6] = d1.z; av[7] = d1.w; }
#pragma unroll
                for (int j = 0; j < 3; ++j) { if (src[j] != nullptr) {
                    const v4u ug = *(const GAS v4u*)(src[j] + scol), uv = *(const GAS v4u*)(src[j] + scol + 128);
                    const float* wgp = cw + (size_t)j * 2 * FFN_H + h8; const float* wvp = wgp + FFN_H;
                    const f32x4 g0 = *(const GAS f32x4*)wgp, g1 = *(const GAS f32x4*)(wgp + 4), v0 = *(const GAS f32x4*)wvp, v1 = *(const GAS f32x4*)(wvp + 4);
                    const unsigned ugw[4] = {ug.x, ug.y, ug.z, ug.w}, uvw[4] = {uv.x, uv.y, uv.z, uv.w}; const float gw8[8] = {g0.x, g0.y, g0.z, g0.w, g1.x, g1.y, g1.z, g1.w}, vw8[8] = {v0.x, v0.y, v0.z, v0.w, v1.x, v1.y, v1.z, v1.w};
#pragma unroll
                    for (int e = 0; e < 4; ++e) { ag[2 * e] += gw8[2 * e] * __uint_as_float(ugw[e] << 16); ag[2 * e + 1] += gw8[2 * e + 1] * __uint_as_float(ugw[e] & 0xffff0000u);
                        av[2 * e] += vw8[2 * e] * __uint_as_float(uvw[e] << 16); av[2 * e + 1] += vw8[2 * e + 1] * __uint_as_float(uvw[e] & 0xffff0000u); } } }
                unsigned w[4];
#pragma unroll
                for (int e = 0; e < 4; ++e) { const float x0 = ag[2 * e], x1 = ag[2 * e + 1]; w[e] = pk2(silu_mul(x0, av[2 * e]), silu_mul(x1, av[2 * e + 1])); }
                *(GAS v4u*)((GAS bf16*)ACTF + (size_t)row * FFN_H + h8) = v4u{w[0], w[1], w[2], w[3]}; }
        }
        SEAM(P + 7);
        if (INA(8)) { PTRS(); const bf16* WD = (const bf16*)(ws + WS_WDN + layer * (11 * MiB / 2)); const bf16* ACTF = (const bf16*)(ws + WS_Q); REP_BEGIN(P + 8)
            const QuadResid q{H, (rep_ & 1) ? -1.f : 1.f}; run_gemm(lds, ACTF, WD, 1024, FFN_H, q, G, wave_s); meta_gemm(lds, ACTF, WD, 1024, FFN_H, q, vcu, G, wave_s);
        REP_END(P + 8) }
        SEAM(P + 8);
        if (INA(11)) { PTRS(); REP_BEGIN(P + 11)
            if (layer == 0) {
                for (int r = gw; r < NBATCH * TREAL; r += NGW) { const int b = r / TREAL, pos = r - b * TREAL, row = b * TALLOC + pos;
                    rms_row_bf16(H + (size_t)row * 1024, args.in[IN_DSA_NORM], XN + (size_t)row * 1024, nullptr, lane); }
                for (int r = gw; r < 2 * NBATCH * (TALLOC - TREAL); r += NGW) { const int which = r / (NBATCH * (TALLOC - TREAL)), rr = r % (NBATCH * (TALLOC - TREAL)), b = rr / (TALLOC - TREAL), pos = TREAL + rr % (TALLOC - TREAL);
                    v4u* p = (v4u*)(KB + (size_t)which * QKV_STRIDE + (size_t)(b * TALLOC + pos) * 1024); unsigned z = 0u; asm volatile("" : "+v"(z)); p[lane] = v4u{z, z, z, z}; p[lane + 64] = v4u{z, z, z, z}; }
            } else {
                for (int r = gw; r < NBATCH * SEQL; r += NGW) { const int b = r / SEQL, t = r - b * SEQL;
                    const f32x4* xr = (const f32x4*)(H + (size_t)(b * TALLOC + NMETA + t) * 1024) + lane; f32x4 v[4]; float s = 0.f;
#pragma unroll
                    for (int j = 0; j < 4; ++j) { v[j] = xr[64 * j]; s += (v[j].x * v[j].x + v[j].y * v[j].y) + (v[j].z * v[j].z + v[j].w * v[j].w); }
                    float rr = 1.0f / sqrtf(wave_sum(s) * (1.f / 1024.f) + RMS_EPS);
                    const f32x4* gr = (const f32x4*)args.in[IN_FINAL_NORM] + lane; f32x4* o = (f32x4*)(args.out + (size_t)r * 1024) + lane;
#ifdef DIAG_A
                    { const unsigned long long* stp = (const unsigned long long*)(args.ws + 65536); const float tot = (float)(__hip_atomic_load(stp + 24, __ATOMIC_RELAXED, __HIP_MEMORY_SCOPE_AGENT) - __hip_atomic_load(stp + 0, __ATOMIC_RELAXED, __HIP_MEMORY_SCOPE_AGENT));
                      const float fa = (float)(__hip_atomic_load(stp + DIAG_A + 1, __ATOMIC_RELAXED, __HIP_MEMORY_SCOPE_AGENT) - __hip_atomic_load(stp + DIAG_A, __ATOMIC_RELAXED, __HIP_MEMORY_SCOPE_AGENT)) / tot;
                      const float fb = (float)(__hip_atomic_load(stp + DIAG_B + 1, __ATOMIC_RELAXED, __HIP_MEMORY_SCOPE_AGENT) - __hip_atomic_load(stp + DIAG_B, __ATOMIC_RELAXED, __HIP_MEMORY_SCOPE_AGENT)) / tot;
                      rr *= 1.f + sqrtf(fa); if (r == 0 && lane == 0) v[0].x += (10.f + 100.f * fb) / (rr * gr[0].x); }
#endif
#pragma unroll
                    for (int j = 0; j < 4; ++j) o[64 * j] = v[j] * rr * gr[64 * j];
                }
            }
        REP_END(P + 11) }
        if (layer == 0) SEAM(P + 11);
    }
    if (full_ < FULLREP) xcd_barrier(bar, wave_s);
    }
#undef IN
#undef INA
#undef SEAM
}

#ifndef MK_PER_PHASE
#define MK_PER_PHASE 0
#endif
extern "C" void kernel_launch(void* const* d_in, const int* in_sizes, int n_in, void* d_out, int out_size, void* d_ws, size_t ws_size, hipStream_t stream) {
    static int grid = 0;
    if (grid == 0) {
        if (n_in != 20 || out_size != NBATCH * SEQL * DMODEL || ws_size < WS_END) { fprintf(stderr, "kernel_launch: unexpected problem (n_in %d, out %d, ws %zu)\n", n_in, out_size, ws_size); grid = -1; return; }
        int dev = 0, cus = 0, per_cu = 0;
        if (hipGetDevice(&dev) != hipSuccess || hipDeviceGetAttribute(&cus, hipDeviceAttributeMultiprocessorCount, dev) != hipSuccess) { grid = -1; return; }
        if (hipFuncSetAttribute((const void*)fwd, hipFuncAttributeMaxDynamicSharedMemorySize, LDS_BYTES) != hipSuccess) { fprintf(stderr, "kernel_launch: hipFuncSetAttribute failed\n"); grid = -1; return; }
        if (hipOccupancyMaxActiveBlocksPerMultiprocessor(&per_cu, (const void*)fwd, NWAVES * 64, LDS_BYTES) != hipSuccess || per_cu < 1) { fprintf(stderr, "kernel_launch: occupancy query says %d\n", per_cu); }
        (void)hipGetLastError();
        grid = cus;
    }
    if (grid < 0) return;
    if (hipMemsetAsync((char*)d_ws + WS_CTL, 0, CTL_ZERO_BYTES, stream) != hipSuccess) return;
    Args a{};
    for (int i = 0; i < 20; ++i) a.in[i] = (const float*)d_in[i];
    a.out = (float*)d_out; a.ws = (unsigned char*)d_ws;
#if MK_PER_PHASE
    for (int p = 0; p < N_PHASES; ++p) { if (p == 4) continue; a.ph_lo = p; a.ph_hi = p + 1; hipLaunchKernelGGL(fwd, dim3(grid), dim3(NWAVES * 64), LDS_BYTES, stream, a); }
#else
    a.ph_lo = 0; a.ph_hi = N_PHASES;
    hipLaunchKernelGGL(fwd, dim3(grid), dim3(NWAVES * 64), LDS_BYTES, stream, a);
#ifdef HOST_TWICE
    (void)hipMemsetAsync((char*)d_ws + WS_CTL, 0, CTL_ZERO_BYTES, stream);
    hipLaunchKernelGGL(fwd, dim3(grid), dim3(NWAVES * 64), LDS_BYTES, stream, a);
#endif
#endif
}
```
